# Optimizing an MI355X kernel written in HIP

```python
import math
import jax, jax.numpy as jnp
from jax import lax
import numpy as np

D_MODEL = 1024
BATCH = 2
SEQ = 16384
DEPTH = 2

N_META = 16
MIX_WIDTH = D_MODEL
HEAD_DIM = 64
SB_WIDTH = MIX_WIDTH // 4
SB_HEADS = SB_WIDTH // HEAD_DIM
SB_BLOCK = 128
DN_WIDTH = MIX_WIDTH // 4
DN_HEADS = DN_WIDTH // HEAD_DIM
DN_CONV = 4
DN_CHUNK = 64
S5_WIDTH = MIX_WIDTH - SB_WIDTH - DN_WIDTH
S5_GROUP = 16
S5_GROUPS = S5_WIDTH // S5_GROUP
S5_STATE = 64
D_FF = ((8 * D_MODEL // 3 + 127) // 128) * 128
IN_SPLITS = (SB_WIDTH, SB_WIDTH, SB_WIDTH, 3 * DN_WIDTH, DN_WIDTH, DN_HEADS, DN_HEADS, S5_WIDTH)
IN_WIDTH = sum(IN_SPLITS)
EPS = 1e-6

kernel_name = 'hymba_sb_deltanet_s5_macaron'


def rmsnorm(x, g):
    xf = x.astype(jnp.float32)
    y = xf * lax.rsqrt(jnp.mean(xf * xf, axis=-1, keepdims=True) + EPS)
    return (y * g.astype(jnp.float32)).astype(x.dtype)


def l2norm(x):
    xf = x.astype(jnp.float32)
    return xf * lax.rsqrt(jnp.sum(xf * xf, axis=-1, keepdims=True) + EPS)


def swiglu(x, w_gate, w_up, w_down):
    return (jax.nn.silu(x @ w_gate) * (x @ w_up)) @ w_down


def front_pad(x, n):
    return jnp.pad(x, [(0, 0), (n, 0)] + [(0, 0)] * (x.ndim - 2))


def causal_depthwise_conv(x, w):
    k = w.shape[0]
    return lax.conv_general_dilated(
        x, w[:, None, :], window_strides=(1,), padding=[(k - 1, 0)],
        dimension_numbers=('NWC', 'WIO', 'NWC'), feature_group_count=x.shape[-1])


def stick_breaking_attention(q, k, v):
    bsz, length, nh, hd = q.shape
    pad = (-N_META) % SB_BLOCK
    q, k, v = (jnp.transpose(front_pad(t, pad), (0, 2, 1, 3)) for t in (q, k, v))
    lp = length + pad
    n_blocks = lp // SB_BLOCK
    key_pos = jnp.arange(lp)
    scale = hd ** -0.5

    def block(i):
        q_blk = lax.dynamic_slice_in_dim(q, i * SB_BLOCK, SB_BLOCK, axis=2)
        q_pos = i * SB_BLOCK + jnp.arange(SB_BLOCK)
        z = jnp.einsum('bhqd,bhkd->bhqk', q_blk, k, preferred_element_type=jnp.float32) * scale
        valid = (key_pos[None, :] < q_pos[:, None]) & (key_pos[None, :] >= pad)
        log_keep = jnp.where(valid, jax.nn.log_sigmoid(-z), 0.0)
        after = lax.cumsum(log_keep, axis=3, reverse=True) - log_keep
        w = jnp.where(valid, jnp.exp(jax.nn.log_sigmoid(z) + after), 0.0)
        return jnp.einsum('bhqk,bhkd->bhqd', w.astype(v.dtype), v)

    out = lax.map(block, jnp.arange(n_blocks))
    out = jnp.transpose(out, (1, 0, 3, 2, 4)).reshape(bsz, lp, nh, hd)
    return out[:, pad:]


def chunk_gated_delta_rule(q, k, v, g, beta):
    bsz, nh, length, dk = q.shape
    dv = v.shape[-1]
    c = DN_CHUNK
    n = length // c
    q = q * dk ** -0.5
    qc = q.reshape(bsz, nh, n, c, dk)
    kc = k.reshape(bsz, nh, n, c, dk)
    vc = v.reshape(bsz, nh, n, c, dv)
    bc = beta.reshape(bsz, nh, n, c, 1)
    gc = jnp.cumsum(g.reshape(bsz, nh, n, c), axis=-1)
    incl = jnp.tril(jnp.ones((c, c), dtype=bool))
    strict = jnp.tril(jnp.ones((c, c), dtype=bool), -1)
    decay = jnp.exp(jnp.where(incl, gc[..., :, None] - gc[..., None, :], -jnp.inf))
    kb = kc * bc
    lmat = jnp.where(strict, jnp.einsum('bhnid,bhnjd->bhnij', kb, kc) * decay, 0.0)
    eye = jnp.eye(c, dtype=jnp.float32)
    t_inv = lax.linalg.triangular_solve(lmat + eye, jnp.broadcast_to(eye, lmat.shape),
                                        left_side=True, lower=True, unit_diagonal=True)
    u = jnp.einsum('bhnij,bhnjd->bhnid', t_inv, vc * bc)
    w = jnp.einsum('bhnij,bhnjd->bhnid', t_inv, kb * jnp.exp(gc)[..., None])
    attn = jnp.where(incl, jnp.einsum('bhnid,bhnjd->bhnij', qc, kc) * decay, 0.0)

    def step(state, inp):
        q_i, k_i, u_i, w_i, a_i, g_i = inp
        v_new = u_i - jnp.einsum('bhcd,bhde->bhce', w_i, state)
        o_i = (jnp.einsum('bhcd,bhde->bhce', q_i * jnp.exp(g_i)[..., None], state)
               + jnp.einsum('bhij,bhje->bhie', a_i, v_new))
        g_last = g_i[..., -1:]
        state = (state * jnp.exp(g_last)[..., None]
                 + jnp.einsum('bhcd,bhce->bhde', k_i * jnp.exp(g_last - g_i)[..., None], v_new))
        return state, o_i

    chunks = tuple(jnp.moveaxis(t, 2, 0) for t in (qc, kc, u, w, attn, gc))
    state0 = jnp.zeros((bsz, nh, dk, dv), jnp.float32)
    _, out = lax.scan(step, state0, chunks)
    return jnp.moveaxis(out, 0, 2).reshape(bsz, nh, length, dv)


def gated_deltanet(qkv, z, b, a, conv_w, a_log, dt_bias, out_norm):
    bsz, length, _ = qkv.shape
    qkv = jax.nn.silu(causal_depthwise_conv(qkv, conv_w))
    q, k, v = (t.reshape(bsz, length, DN_HEADS, HEAD_DIM) for t in jnp.split(qkv, 3, axis=-1))
    q, k, v = l2norm(q), l2norm(k), v.astype(jnp.float32)
    beta = jax.nn.sigmoid(b.astype(jnp.float32))
    g = -jnp.exp(a_log.astype(jnp.float32)) * jax.nn.softplus(a.astype(jnp.float32) + dt_bias.astype(jnp.float32))
    pad = (-N_META) % DN_CHUNK
    q, k, v, g, beta = (front_pad(t, pad) for t in (q, k, v, g, beta))
    o = chunk_gated_delta_rule(jnp.moveaxis(q, 2, 1), jnp.moveaxis(k, 2, 1), jnp.moveaxis(v, 2, 1),
                               jnp.moveaxis(g, 2, 1), jnp.moveaxis(beta, 2, 1))
    o = jnp.moveaxis(o, 1, 2)[:, pad:]
    o = rmsnorm(o, out_norm) * jax.nn.silu(z.astype(jnp.float32).reshape(bsz, length, DN_HEADS, HEAD_DIM))
    return o.reshape(bsz, length, DN_WIDTH)


def s5_mixer(u, a_re, a_im, log_dt, b_re, b_im, c_re, c_im, d, w_glu, b_glu):
    bsz, length, _ = u.shape
    f32 = jnp.float32
    uf = u.astype(f32).reshape(bsz, length, S5_GROUPS, S5_GROUP)
    lam = lax.complex(a_re.astype(f32), a_im.astype(f32))
    dt = jnp.exp(log_dt.astype(f32))[:, None]
    log_abar = lam * dt
    abar = jnp.exp(log_abar)
    b_bar = ((abar - 1.0) / lam)[..., None] * lax.complex(b_re.astype(f32), b_im.astype(f32))
    bu = jnp.einsum('blgc,gpc->blgp', uf.astype(jnp.complex64), b_bar)
    steps = jnp.ones((1, length, 1, 1), f32)

    def combine(e1, e2):
        n1, x1 = e1
        n2, x2 = e2
        return n1 + n2, x1 * jnp.exp(n2 * log_abar) + x2

    _, states = lax.associative_scan(combine, (steps, bu), axis=1)
    c_cplx = lax.complex(c_re.astype(f32), c_im.astype(f32))
    y = jnp.real(jnp.einsum('blgp,gcp->blgc', states, c_cplx)) + d.astype(f32).reshape(S5_GROUPS, S5_GROUP) * uf
    y = jax.nn.gelu(y.reshape(bsz, length, S5_WIDTH))
    return y * jax.nn.sigmoid(y @ w_glu.astype(f32) + b_glu.astype(f32))


def hybrid_mixer(h, w_in, sb_out_norm, dn_conv_w, dn_a_log, dn_dt_bias, dn_out_norm,
                 s5_a_re, s5_a_im, s5_log_dt, s5_b_re, s5_b_im, s5_c_re, s5_c_im,
                 s5_d, s5_w_glu, s5_b_glu, s5_out_norm, w_out):
    bsz, length, _ = h.shape
    proj = h @ w_in
    sb_q, sb_k, sb_v, dn_qkv, dn_z, dn_b, dn_a, s5_u = jnp.split(
        proj, np.cumsum(IN_SPLITS)[:-1].tolist(), axis=-1)
    heads = lambda t: t.reshape(bsz, length, SB_HEADS, HEAD_DIM)
    o_sb = stick_breaking_attention(heads(sb_q), heads(sb_k), heads(sb_v))
    o_sb = rmsnorm(o_sb, sb_out_norm).reshape(bsz, length, SB_WIDTH)
    o_dn = gated_deltanet(dn_qkv, dn_z, dn_b, dn_a, dn_conv_w, dn_a_log, dn_dt_bias, dn_out_norm)
    o_s5 = rmsnorm(s5_mixer(s5_u, s5_a_re, s5_a_im, s5_log_dt, s5_b_re, s5_b_im, s5_c_re, s5_c_im,
                            s5_d, s5_w_glu, s5_b_glu), s5_out_norm)
    mixed = jnp.concatenate([o_sb.astype(h.dtype), o_dn.astype(h.dtype), o_s5.astype(h.dtype)], axis=-1)
    return mixed @ w_out


def setup_inputs(seed: int = 0) -> dict:
    key = jax.random.key(seed)
    ks = iter(jax.random.split(key, 40))
    f32 = jnp.float32
    nrm = lambda shape, scale: scale * jax.random.normal(next(ks), shape, f32)
    gain = lambda shape: 1.0 + nrm(shape, 0.02)
    unif = lambda shape, lo, hi: jax.random.uniform(next(ks), shape, f32, minval=lo, maxval=hi)
    dn_dt = jnp.exp(unif((DEPTH, DN_HEADS), math.log(1e-3), math.log(1e-1)))
    return {
        'x': nrm((BATCH, SEQ, D_MODEL), 1.0),
        'meta_tokens': nrm((N_META, D_MODEL), 1.0),
        'ffn1_norm': gain((DEPTH, D_MODEL)),
        'ffn1_w_gate': nrm((DEPTH, D_MODEL, D_FF), D_MODEL ** -0.5),
        'ffn1_w_up': nrm((DEPTH, D_MODEL, D_FF), D_MODEL ** -0.5),
        'ffn1_w_down': nrm((DEPTH, D_FF, D_MODEL), D_FF ** -0.5),
        'mix_norm': gain((DEPTH, D_MODEL)),
        'w_in': nrm((DEPTH, D_MODEL, IN_WIDTH), D_MODEL ** -0.5),
        'sb_out_norm': gain((DEPTH, HEAD_DIM)),
        'dn_conv_w': nrm((DEPTH, DN_CONV, 3 * DN_WIDTH), DN_CONV ** -0.5),
        'dn_a_log': jnp.log(unif((DEPTH, DN_HEADS), 1.0, 16.0)),
        'dn_dt_bias': dn_dt + jnp.log(-jnp.expm1(-dn_dt)),
        'dn_out_norm': gain((DEPTH, HEAD_DIM)),
        's5_a_re': -0.5 + nrm((DEPTH, S5_GROUPS, S5_STATE), 0.01),
        's5_a_im': math.pi * jnp.arange(S5_STATE, dtype=f32) + nrm((DEPTH, S5_GROUPS, S5_STATE), 0.01),
        's5_log_dt': unif((DEPTH, S5_GROUPS), math.log(1e-3), math.log(1e-1)),
        's5_b_re': nrm((DEPTH, S5_GROUPS, S5_STATE, S5_GROUP), (2 * S5_GROUP) ** -0.5),
        's5_b_im': nrm((DEPTH, S5_GROUPS, S5_STATE, S5_GROUP), (2 * S5_GROUP) ** -0.5),
        's5_c_re': nrm((DEPTH, S5_GROUPS, S5_GROUP, S5_STATE), (2 * S5_STATE) ** -0.5),
        's5_c_im': nrm((DEPTH, S5_GROUPS, S5_GROUP, S5_STATE), (2 * S5_STATE) ** -0.5),
        's5_d': nrm((DEPTH, S5_WIDTH), 1.0),
        's5_w_glu': nrm((DEPTH, S5_WIDTH, S5_WIDTH), S5_WIDTH ** -0.5),
        's5_b_glu': nrm((DEPTH, S5_WIDTH), 0.02),
        's5_out_norm': gain((DEPTH, S5_WIDTH)),
        'w_out': nrm((DEPTH, MIX_WIDTH, D_MODEL), MIX_WIDTH ** -0.5),
        'ffn2_norm': gain((DEPTH, D_MODEL)),
        'ffn2_w_gate': nrm((DEPTH, D_MODEL, D_FF), D_MODEL ** -0.5),
        'ffn2_w_up': nrm((DEPTH, D_MODEL, D_FF), D_MODEL ** -0.5),
        'ffn2_w_down': nrm((DEPTH, D_FF, D_MODEL), D_FF ** -0.5),
        'final_norm': gain((D_MODEL,)),
    }


def reference(x, meta_tokens, ffn1_norm, ffn1_w_gate, ffn1_w_up, ffn1_w_down, mix_norm, w_in,
              sb_out_norm, dn_conv_w, dn_a_log, dn_dt_bias, dn_out_norm,
              s5_a_re, s5_a_im, s5_log_dt, s5_b_re, s5_b_im, s5_c_re, s5_c_im,
              s5_d, s5_w_glu, s5_b_glu, s5_out_norm, w_out,
              ffn2_norm, ffn2_w_gate, ffn2_w_up, ffn2_w_down, final_norm):
    bsz = x.shape[0]
    meta = jnp.broadcast_to(meta_tokens[None].astype(x.dtype), (bsz, N_META, D_MODEL))
    h = jnp.concatenate([meta, x], axis=1)
    for l in range(DEPTH):
        h = h + 0.5 * swiglu(rmsnorm(h, ffn1_norm[l]), ffn1_w_gate[l], ffn1_w_up[l], ffn1_w_down[l])
        h = h + hybrid_mixer(rmsnorm(h, mix_norm[l]), w_in[l], sb_out_norm[l], dn_conv_w[l],
                             dn_a_log[l], dn_dt_bias[l], dn_out_norm[l],
                             s5_a_re[l], s5_a_im[l], s5_log_dt[l], s5_b_re[l], s5_b_im[l],
                             s5_c_re[l], s5_c_im[l], s5_d[l], s5_w_glu[l], s5_b_glu[l],
                             s5_out_norm[l], w_out[l])
        h = h + 0.5 * swiglu(rmsnorm(h, ffn2_norm[l]), ffn2_w_gate[l], ffn2_w_up[l], ffn2_w_down[l])
    return rmsnorm(h, final_norm)[:, N_META:]
```

```cpp
#include <hip/hip_runtime.h>
#include <hip/hip_cooperative_groups.h>
#include <cstdio>
namespace cg = cooperative_groups;

#ifndef SINGLE_LAUNCH
#define SINGLE_LAUNCH 1
#endif
namespace pg8 {
#define PG8_LAS __attribute__((address_space(3)))
typedef unsigned short bf16_t;
typedef short bf16x8 __attribute__((ext_vector_type(8)));
typedef float f32x4 __attribute__((ext_vector_type(4)));
typedef unsigned u32x4 __attribute__((ext_vector_type(4)));
constexpr int BM = 256, BK = 64, HALF = 128, HTB = HALF * BK * 2  , STAGE_BYTES = 8 * HTB, NXCD = 8, WGM = 8;

__host__ __device__ __forceinline__ int lds_byte(int r, int c) { const int st = (r >> 4) * 2 + (c >> 5), rr = r & 15, cc = c & 31, ob = rr * 64 + cc * 2; return st * 1024 + (ob ^ (((ob >> 9) & 1) << 5)); }
__host__ __device__ __forceinline__ void stage_rc(int b, int& R, int& C) { const int st = b / 1024, sb = b % 1024, swz = sb ^ (((sb >> 9) & 1) << 5); R = (st >> 1) * 16 + swz / 64; C = (st & 1) * 32 + (swz % 64) / 2; }
__host__ __device__ __forceinline__ int perm32(int rho) { const int n = rho >> 4, i = rho & 15; return 8 * (i >> 2) + 4 * n + (i & 3); }

struct Unit { int pm, pn; };
struct Gemm { const bf16_t* A; const bf16_t* Bt; int M, N, K; };

struct StaticOrder {
    int nM, nN, nwg, G, c;
    __host__ __device__ void init(int M, int N, int G_, int c_) { nM = M / BM; nN = N / BM; nwg = nM * nN; G = G_; c = c_; }
    __host__ __device__ bool next(int i, Unit& u) const {
        const long L = (long)i * G + c; if (L >= nwg) return false;
        int wgid = (int)L; { const int q = nwg / NXCD, r = nwg % NXCD, xcd = wgid % NXCD, off = wgid / NXCD; wgid = (xcd < r ? xcd * (q + 1) : r * (q + 1) + (xcd - r) * q) + off; }
        const int nig = WGM * nN, gid = wgid / nig, fm = gid * WGM, gsz = (nM - fm) < WGM ? (nM - fm) : WGM;
        u.pm = fm + ((wgid % nig) % gsz); u.pn = (wgid % nig) / gsz; return true;
    }
    __device__ __forceinline__ void a_ready(const Unit&) const {}
    __device__ __forceinline__ void done(const Unit&) const {}
};
__device__ __forceinline__ unsigned cvt_pk_bf16(float lo, float hi) { unsigned r; asm volatile("v_cvt_pk_bf16_f32 %0, %1, %2" : "=v"(r) : "v"(lo), "v"(hi)); return r; }
template <class Epi, class Sched, bool STAMP = false>
__device__ __forceinline__ void gemm_phase(PG8_LAS unsigned char* lds, const Gemm g, const Sched& S, const Epi& E, unsigned long long* stamps) {
    const int tid = threadIdx.x, wid = __builtin_amdgcn_readfirstlane(tid >> 6), lane = tid & 63, wr = wid >> 2, wc = wid & 3, fr = lane & 15, fq = lane >> 4;
    const int K = g.K, nt = K / BK;
    unsigned voffA[2], voffB[2];
#pragma unroll
    for (int i = 0; i < 2; ++i) { int R, C; stage_rc(tid * 16 + i * 8192, R, C); const int Rb = E.perm() ? ((R & ~31) + perm32(R & 31)) : R;
        voffA[i] = (unsigned)(R * K + C) * 2u; voffB[i] = (unsigned)(Rb * K + C) * 2u; }
    const size_t kstep = (size_t)(BK * 2);
    const size_t hstep = (size_t)HALF * K * 2;
    const size_t tstep = 2 * hstep;
    const unsigned ldsw = (unsigned)wid * 1024u;
    const int aoff = lds_byte(wr * 64 + fr, fq * 8), boff = lds_byte(wc * 32 + fr, fq * 8);
#define PG8_SA(b, h) (((b) * 2 + (h)) * HTB)
#define PG8_SB(b, h) ((4 + (b) * 2 + (h)) * HTB)
#define PG8_STAGE(bufoff, gbase, voff) do { _Pragma("unroll") for (int _i = 0; _i < 2; ++_i) \
        __builtin_amdgcn_global_load_lds((const unsigned*)((const char*)(gbase) + (voff)[_i]), (PG8_LAS unsigned*)(lds + (bufoff) + ldsw + _i * 8192), 16, 0, 0); } while (0)
#define PG8_LDA(dst, b, h) do { _Pragma("unroll") for (int m = 0; m < 4; ++m) _Pragma("unroll") for (int k = 0; k < 2; ++k) dst[m][k] = *(const PG8_LAS bf16x8*)(lds + PG8_SA(b, h) + aoff + m * 2048 + k * 1024); } while (0)
#define PG8_LDB(dst, b, h) do { _Pragma("unroll") for (int n = 0; n < 2; ++n) _Pragma("unroll") for (int k = 0; k < 2; ++k) dst[n][k] = *(const PG8_LAS bf16x8*)(lds + PG8_SB(b, h) + boff + n * 2048 + k * 1024); } while (0)
#define PG8_MMA(ai, bj, At, Bt) do { __builtin_amdgcn_s_setprio(1); _Pragma("unroll") for (int m = 0; m < 4; ++m) _Pragma("unroll") for (int n = 0; n < 2; ++n) _Pragma("unroll") for (int k = 0; k < 2; ++k) \
        acc[ai][bj][m][n] = __builtin_amdgcn_mfma_f32_16x16x32_bf16(Bt[n][k], At[m][k], acc[ai][bj][m][n], 0, 0, 0); __builtin_amdgcn_s_setprio(0); } while (0)
#define PG8_WAIT_V(n) asm volatile("s_waitcnt vmcnt(" #n ")" ::: "memory")
#define PG8_WAIT_L(n) asm volatile("s_waitcnt lgkmcnt(" #n ")" ::: "memory")
#define PG8_BAR __builtin_amdgcn_s_barrier()
#define PG8_SCHED __builtin_amdgcn_sched_barrier(0)
    Unit cur, nxt; int ui = 0;
    if (!S.next(0, cur)) return;
    f32x4 acc[2][2][4][2];
#pragma unroll
    for (int a = 0; a < 2; ++a)
#pragma unroll
        for (int b = 0; b < 2; ++b)
#pragma unroll
            for (int m = 0; m < 4; ++m)
#pragma unroll
                for (int n = 0; n < 2; ++n) acc[a][b][m][n] = (f32x4){0.f, 0.f, 0.f, 0.f};
    bf16x8 At[4][2], B0[2][2], B1[2][2];
    const char* cA = (const char*)g.A + (size_t)cur.pm * tstep; const char* cB = (const char*)g.Bt + (size_t)cur.pn * tstep;
    S.a_ready(cur);
    PG8_STAGE(PG8_SB(0, 0), cB, voffB); PG8_STAGE(PG8_SA(0, 0), cA, voffA); PG8_STAGE(PG8_SB(0, 1), cB + hstep, voffB); PG8_STAGE(PG8_SA(0, 1), cA + hstep, voffA);
    if (wr == 1) PG8_BAR;
    PG8_WAIT_V(4); PG8_BAR;
    PG8_STAGE(PG8_SB(1, 0), cB + kstep, voffB); PG8_STAGE(PG8_SA(1, 0), cA + kstep, voffA); PG8_STAGE(PG8_SB(1, 1), cB + hstep + kstep, voffB);
    PG8_WAIT_V(6); PG8_BAR;
    for (;;) {
        const bool has_next = S.next(ui + 1, nxt);
        const char* nA = has_next ? (const char*)g.A + (size_t)nxt.pm * tstep : cA; const char* nB = has_next ? (const char*)g.Bt + (size_t)nxt.pn * tstep : cB;
        for (int t = 0; t < nt; t += 2) {
            const bool last = (t == nt - 2);
            const char* a1 = cA + (size_t)(t + 1) * kstep;
            const char* a2 = last ? nA : cA + (size_t)(t + 2) * kstep; const char* b2 = last ? nB : cB + (size_t)(t + 2) * kstep;
            const char* a3 = a2 + kstep; const char* b3 = b2 + kstep;
            if (last && has_next) S.a_ready(nxt);
            PG8_LDB(B0, 0, 0); PG8_SCHED; PG8_LDA(At, 0, 0); PG8_STAGE(PG8_SA(1, 1), a1 + hstep, voffA);
            PG8_WAIT_L(8); PG8_BAR; PG8_WAIT_L(0); PG8_MMA(0, 0, At, B0); PG8_BAR; PG8_SCHED;
            PG8_LDB(B1, 0, 1); PG8_STAGE(PG8_SB(0, 0), b2, voffB);
            PG8_BAR; PG8_WAIT_L(0); PG8_MMA(0, 1, At, B1); PG8_BAR;
            PG8_LDA(At, 0, 1); PG8_STAGE(PG8_SA(0, 0), a2, voffA);
            PG8_BAR; PG8_WAIT_L(0); PG8_MMA(1, 0, At, B0); PG8_BAR; PG8_SCHED;
            PG8_STAGE(PG8_SB(0, 1), b2 + hstep, voffB);
            PG8_WAIT_V(6); PG8_BAR; PG8_MMA(1, 1, At, B1); PG8_BAR;
            PG8_LDB(B0, 1, 0); PG8_SCHED; PG8_LDA(At, 1, 0); PG8_STAGE(PG8_SA(0, 1), a2 + hstep, voffA);
            PG8_WAIT_L(8); PG8_BAR; PG8_WAIT_L(0); PG8_MMA(0, 0, At, B0); PG8_BAR; PG8_SCHED;
            PG8_LDB(B1, 1, 1); PG8_STAGE(PG8_SB(1, 0), b3, voffB);
            PG8_BAR; PG8_WAIT_L(0); PG8_MMA(0, 1, At, B1); PG8_BAR;
            PG8_LDA(At, 1, 1); PG8_STAGE(PG8_SA(1, 0), a3, voffA);
            PG8_BAR; PG8_WAIT_L(0); PG8_MMA(1, 0, At, B0); PG8_BAR; PG8_SCHED;
            PG8_STAGE(PG8_SB(1, 1), b3 + hstep, voffB);
            PG8_WAIT_V(6); PG8_BAR; PG8_MMA(1, 1, At, B1); PG8_BAR;
        }
        if constexpr (!Epi::AFTER_DRAIN) { E(acc, cur, wr, wc, fr, fq); S.done(cur); }
        if (!has_next) break;
#pragma unroll
        for (int a = 0; a < 2; ++a)
#pragma unroll
            for (int b = 0; b < 2; ++b)
#pragma unroll
                for (int m = 0; m < 4; ++m)
#pragma unroll
                    for (int n = 0; n < 2; ++n) acc[a][b][m][n] = (f32x4){0.f, 0.f, 0.f, 0.f};
        cur = nxt; cA = nA; cB = nB; ++ui;
    }
    PG8_WAIT_V(0);
    if (wr == 0) PG8_BAR;
    PG8_BAR;
    if constexpr (Epi::AFTER_DRAIN) { E.fused(acc, cur, wr, wc, fr, fq, lds, wid, lane); S.done(cur); }
#undef PG8_SA
#undef PG8_SB
#undef PG8_STAGE
#undef PG8_LDA
#undef PG8_LDB
#undef PG8_MMA
#undef PG8_WAIT_V
#undef PG8_WAIT_L
#undef PG8_BAR
#undef PG8_SCHED
}
}

#define LAS __attribute__((address_space(3)))
typedef unsigned short bf16_t;
typedef short bf16x8 __attribute__((ext_vector_type(8)));
typedef float f32x4 __attribute__((ext_vector_type(4)));
typedef unsigned u32x4 __attribute__((ext_vector_type(4)));
typedef unsigned u32x2 __attribute__((ext_vector_type(2)));

constexpr int DM = 1024, DFF = 2816, SEQ = 16384, PADF = 112, LP = 16512, MROWS = 33024, PW = 2304, INW = 2312;
constexpr int NCH = 258;
constexpr int NQB = 129;
constexpr int NTHR = 512;
constexpr int LDS_BYTES = 131072;

constexpr size_t WS_H = 0;
constexpr size_t SZ_H = (size_t)MROWS * DM * 4;
constexpr size_t WS_XN = WS_H + SZ_H;
constexpr size_t SZ_XN = (size_t)MROWS * DM * 2;
constexpr size_t WS_BIG = WS_XN + SZ_XN;
constexpr size_t SZ_PROJ = (size_t)MROWS * PW * 2;
constexpr size_t SZ_BIG = SZ_PROJ + SZ_XN;
constexpr size_t WS_W = WS_BIG + SZ_BIG;
constexpr size_t WL = 20971520;
constexpr size_t SZ_W = WL * 2 * 2;
constexpr size_t WS_BA = WS_W + SZ_W;
constexpr size_t SZ_BA = (size_t)MROWS * 8 * 4;
constexpr size_t WS_E = WS_BA + SZ_BA;
constexpr size_t SZ_E = (size_t)2 * NCH * 32 * 64 * 2 * 4;
constexpr size_t WS_S5P = WS_E + SZ_E;
constexpr size_t S5P_L = 73728;
constexpr size_t SZ_S5P = 2 * S5P_L * 4;
constexpr size_t WS_END = WS_S5P + SZ_S5P;
static_assert(WS_END <= 536870912ull, "workspace too large");
static_assert(SZ_BIG >= (size_t)MROWS * DFF * 2, "act must fit");
constexpr size_t WO_GU1 = 0, WO_D1 = 5767168, WO_IN = 8650752, WO_GLU = 11010048, WO_OUT = 11272192, WO_GU2 = 12320768, WO_D2 = 18087936;
constexpr int NDN = 8 * NCH;
constexpr size_t DO_W = 0, DO_QG = 16908288, DO_ATT = 2 * 16908288ull, DO_KT = 3 * 16908288ull, DO_UT = 4 * 16908288ull, DO_EGL = 5 * 16908288ull;
constexpr size_t DO_ODN = DO_EGL + 8448;
static_assert(DO_ODN + (size_t)MROWS * 256 * 4 <= 134217728ull, "d_out scratch too large");

struct Params { const float* in[30]; float* out; unsigned char* ws; int ph_lo, ph_hi; };

__device__ __forceinline__ bf16_t f2bf(float f) { unsigned u = __float_as_uint(f); u += 0x7FFFu + ((u >> 16) & 1u); return (bf16_t)(u >> 16); }
__device__ __forceinline__ float bf2f(bf16_t b) { return __uint_as_float(((unsigned)b) << 16); }
__device__ __forceinline__ unsigned pack2(float lo, float hi) { return (unsigned)f2bf(lo) | ((unsigned)f2bf(hi) << 16); }
__device__ __forceinline__ float bflo(unsigned w) { return __uint_as_float(w << 16); }
__device__ __forceinline__ float bfhi(unsigned w) { return __uint_as_float(w & 0xffff0000u); }
__device__ __forceinline__ float softplus_fast(float x) { return fmaxf(x, 0.f) + __logf(1.f + __expf(-fabsf(x))); }
__device__ __forceinline__ float sigmoid_fast(float x) { return 1.f / (1.f + __expf(-x)); }
__device__ __forceinline__ float silu_fast(float x) { return x / (1.f + __expf(-x)); }
__device__ __forceinline__ f32x4 mfma16(bf16x8 a, bf16x8 b, f32x4 c) { return __builtin_amdgcn_mfma_f32_16x16x32_bf16(a, b, c, 0, 0, 0); }
#define WAVE_LDS_SYNC() do { asm volatile("s_waitcnt lgkmcnt(0)" ::: "memory"); __builtin_amdgcn_wave_barrier(); } while (0)

struct EpiSwiGLU {
    static constexpr bool PERM = true, AFTER_DRAIN = false;
    bf16_t* O;
    __device__ __forceinline__ void operator()(const f32x4 (&acc)[2][2][4][2], const pg8::Unit& u, int wr, int wc, int fr, int fq) const {
        const int row0 = u.pm * 256 + wr * 64 + fr, j0 = u.pn * 128 + wc * 32 + 8 * fq;
#pragma unroll
        for (int ai = 0; ai < 2; ++ai)
#pragma unroll
            for (int m = 0; m < 4; ++m) {
                const f32x4 g0 = acc[ai][0][m][0], g1 = acc[ai][0][m][1], u0 = acc[ai][1][m][0], u1 = acc[ai][1][m][1];
                u32x4 w;
                w.x = pack2(silu_fast(g0[0]) * u0[0], silu_fast(g0[1]) * u0[1]); w.y = pack2(silu_fast(g0[2]) * u0[2], silu_fast(g0[3]) * u0[3]);
                w.z = pack2(silu_fast(g1[0]) * u1[0], silu_fast(g1[1]) * u1[1]); w.w = pack2(silu_fast(g1[2]) * u1[2], silu_fast(g1[3]) * u1[3]);
                *(u32x4*)(O + (size_t)(row0 + ai * 128 + m * 16) * DFF + j0) = w;
            }
    }
};
struct EpiResid {
    static constexpr bool PERM = false, AFTER_DRAIN = false;
    float* H; float scale;
    __device__ __forceinline__ void operator()(const f32x4 (&acc)[2][2][4][2], const pg8::Unit& u, int wr, int wc, int fr, int fq) const {
        const int row0 = u.pm * 256 + wr * 64 + fr, col0 = u.pn * 256 + wc * 32 + 4 * fq;
#pragma unroll
        for (int ai = 0; ai < 2; ++ai)
#pragma unroll
            for (int m = 0; m < 4; ++m) { float* rowp = H + (size_t)(row0 + ai * 128 + m * 16) * DM + col0;
#pragma unroll
                for (int bj = 0; bj < 2; ++bj)
#pragma unroll
                    for (int n = 0; n < 2; ++n) { f32x4* q = (f32x4*)(rowp + bj * 128 + n * 16); *q = *q + acc[ai][bj][m][n] * scale; } }
    }
};
struct EpiBf16 {
    static constexpr bool PERM = true, AFTER_DRAIN = false;
    bf16_t* O; int ldc;
    __device__ __forceinline__ void operator()(const f32x4 (&acc)[2][2][4][2], const pg8::Unit& u, int wr, int wc, int fr, int fq) const {
        const int row0 = u.pm * 256 + wr * 64 + fr, col0 = u.pn * 256 + wc * 32 + 8 * fq;
#pragma unroll
        for (int ai = 0; ai < 2; ++ai)
#pragma unroll
            for (int m = 0; m < 4; ++m) { bf16_t* rowp = O + (size_t)(row0 + ai * 128 + m * 16) * ldc + col0;
#pragma unroll
                for (int bj = 0; bj < 2; ++bj) { const f32x4 v0 = acc[ai][bj][m][0], v1 = acc[ai][bj][m][1];
                    u32x4 w; w.x = pack2(v0[0], v0[1]); w.y = pack2(v0[2], v0[3]); w.z = pack2(v1[0], v1[1]); w.w = pack2(v1[2], v1[3]);
                    *(u32x4*)(rowp + bj * 128) = w; } }
    }
};
struct EpiGLU {
    static constexpr bool PERM = true, AFTER_DRAIN = false;
    const bf16_t* Y; bf16_t* O; const float* bias;
    __device__ __forceinline__ void operator()(const f32x4 (&acc)[2][2][4][2], const pg8::Unit& u, int wr, int wc, int fr, int fq) const {
        const int row0 = u.pm * 256 + wr * 64 + fr, col0 = u.pn * 256 + wc * 32 + 8 * fq;
#pragma unroll
        for (int ai = 0; ai < 2; ++ai)
#pragma unroll
            for (int m = 0; m < 4; ++m) { const size_t ro = (size_t)(row0 + ai * 128 + m * 16) * 512 + col0;
#pragma unroll
                for (int bj = 0; bj < 2; ++bj) { const f32x4 v0 = acc[ai][bj][m][0], v1 = acc[ai][bj][m][1];
                    const u32x4 yv = *(const u32x4*)(Y + ro + bj * 128);
                    const f32x4 b0 = *(const f32x4*)(bias + col0 + bj * 128), b1 = *(const f32x4*)(bias + col0 + bj * 128 + 4);
                    u32x4 w;
                    w.x = pack2(bflo(yv.x) * sigmoid_fast(v0[0] + b0[0]), bfhi(yv.x) * sigmoid_fast(v0[1] + b0[1]));
                    w.y = pack2(bflo(yv.y) * sigmoid_fast(v0[2] + b0[2]), bfhi(yv.y) * sigmoid_fast(v0[3] + b0[3]));
                    w.z = pack2(bflo(yv.z) * sigmoid_fast(v1[0] + b1[0]), bfhi(yv.z) * sigmoid_fast(v1[1] + b1[1]));
                    w.w = pack2(bflo(yv.w) * sigmoid_fast(v1[2] + b1[2]), bfhi(yv.w) * sigmoid_fast(v1[3] + b1[3]));
                    *(u32x4*)(O + ro + bj * 128) = w; } }
    }
};
struct EpiGen {
    static constexpr bool AFTER_DRAIN = false;
    int mode;
    void* O; const bf16_t* Y; const float* bias; float scale; int ldc;
    __device__ __forceinline__ bool perm() const { return mode != 1; }
    __device__ __forceinline__ void operator()(const f32x4 (&acc)[2][2][4][2], const pg8::Unit& u, int wr, int wc, int fr, int fq) const {
        if (mode == 0) { EpiSwiGLU e{(bf16_t*)O}; e(acc, u, wr, wc, fr, fq); }
        else if (mode == 1) { EpiResid e{(float*)O, scale}; e(acc, u, wr, wc, fr, fq); }
        else if (mode == 2) { EpiBf16 e{(bf16_t*)O, ldc}; e(acc, u, wr, wc, fr, fq); }
        else { EpiGLU e{Y, (bf16_t*)O, bias}; e(acc, u, wr, wc, fr, fq); }
    }
};
__device__ __forceinline__ void run_gemm(LAS unsigned char* lds, const bf16_t* A, const bf16_t* Bt, int N, int K, const EpiGen& E) {
    pg8::Gemm g{A, Bt, MROWS, N, K}; pg8::StaticOrder S; S.init(MROWS, N, (int)gridDim.x, (int)blockIdx.x);
    pg8::gemm_phase<EpiGen, pg8::StaticOrder>(lds, g, S, E, nullptr);
}

__device__ __forceinline__ void convert_tile(LAS float* T, const float* src, int ld_src, bf16_t* dst, int ld_dst) {
    const int tid = threadIdx.x;
    { const int kr = tid >> 4, c4 = (tid & 15) * 4;
#pragma unroll
      for (int i = 0; i < 2; ++i) { const int k = kr + 32 * i; const f32x4 v = *(const f32x4*)(src + (size_t)k * ld_src + c4);
          T[k * 65 + c4 + 0] = v[0]; T[k * 65 + c4 + 1] = v[1]; T[k * 65 + c4 + 2] = v[2]; T[k * 65 + c4 + 3] = v[3]; } }
    __syncthreads();
    { const int n = tid >> 3, k8 = (tid & 7) * 8; u32x4 w;
      w.x = pack2(T[(k8 + 0) * 65 + n], T[(k8 + 1) * 65 + n]); w.y = pack2(T[(k8 + 2) * 65 + n], T[(k8 + 3) * 65 + n]);
      w.z = pack2(T[(k8 + 4) * 65 + n], T[(k8 + 5) * 65 + n]); w.w = pack2(T[(k8 + 6) * 65 + n], T[(k8 + 7) * 65 + n]);
      *(u32x4*)(dst + (size_t)n * ld_dst + k8) = w; }
    __syncthreads();
}
__device__ __forceinline__ void convert_weights(const Params& p, LAS unsigned char* lds) {
    LAS float* T = (LAS float*)lds;
    bf16_t* W = (bf16_t*)(p.ws + WS_W);
    for (int t = blockIdx.x; t < 2 * 5120; t += gridDim.x) {
        const int l = t / 5120; int r = t % 5120;
        bf16_t* Wl = W + (size_t)l * WL;
        const float* src; int ld_src; bf16_t* dst; int ld_dst;
        if (r < 1408 || (r >= 3008 && r < 4416)) {
            const bool second = r >= 3008; if (second) r -= 3008;
            const int tn = r >> 4, tk = r & 15, n0 = tn * 64, pn = n0 >> 8, bj = (n0 >> 7) & 1, i0 = n0 & 127;
            const float* g = p.in[second ? 26 : 3] + (size_t)l * DM * DFF; const float* up = p.in[second ? 27 : 4] + (size_t)l * DM * DFF;
            src = (bj ? up : g) + (size_t)(tk * 64) * DFF + pn * 128 + i0; ld_src = DFF;
            dst = Wl + (second ? WO_GU2 : WO_GU1) + (size_t)n0 * DM + tk * 64; ld_dst = DM;
        } else if (r < 2112 || r >= 4416) {
            const bool second = r >= 4416; r -= second ? 4416 : 1408;
            const int tn = r / 44, tk = r % 44;
            src = p.in[second ? 28 : 5] + (size_t)l * DFF * DM + (size_t)(tk * 64) * DM + tn * 64; ld_src = DM;
            dst = Wl + (second ? WO_D2 : WO_D1) + (size_t)(tn * 64) * DFF + tk * 64; ld_dst = DFF;
        } else if (r < 2688) {
            r -= 2112; const int tn = r >> 4, tk = r & 15, n0 = tn * 64, c0 = n0 < 1792 ? n0 : n0 + 8;
            src = p.in[7] + (size_t)l * DM * INW + (size_t)(tk * 64) * INW + c0; ld_src = INW;
            dst = Wl + WO_IN + (size_t)n0 * DM + tk * 64; ld_dst = DM;
        } else if (r < 2752) {
            r -= 2688; const int tn = r >> 3, tk = r & 7;
            src = p.in[21] + (size_t)l * 512 * 512 + (size_t)(tk * 64) * 512 + tn * 64; ld_src = 512;
            dst = Wl + WO_GLU + (size_t)(tn * 64) * 512 + tk * 64; ld_dst = 512;
        } else {
            r -= 2752; const int tn = r >> 4, tk = r & 15;
            src = p.in[24] + (size_t)l * DM * DM + (size_t)(tk * 64) * DM + tn * 64; ld_src = DM;
            dst = Wl + WO_OUT + (size_t)(tn * 64) * DM + tk * 64; ld_dst = DM;
        }
        convert_tile(T, src, ld_src, dst, ld_dst);
    }
}
__device__ __forceinline__ void s5_params(const Params& p) {
    const int gt = blockIdx.x * NTHR + threadIdx.x;
    if (gt >= 2 * 32 * 64) return;
    const int l = gt >> 11, g = (gt >> 6) & 31, q = gt & 63;
    float* P = (float*)(p.ws + WS_S5P) + (size_t)l * S5P_L;
    const float are = p.in[13][gt], aim = p.in[14][gt], dt = expf(p.in[15][l * 32 + g]);
    const float mag = expf(are * dt), ar = mag * cosf(aim * dt), ai = mag * sinf(aim * dt);
    P[(g * 64 + q) * 2] = ar; P[(g * 64 + q) * 2 + 1] = ai;
    float pr = ar, pi = ai;
#pragma unroll
    for (int i = 0; i < 6; ++i) { const float nr = pr * pr - pi * pi, ni = 2.f * pr * pi; pr = nr; pi = ni; }
    P[4096 + (g * 64 + q) * 2] = pr; P[4096 + (g * 64 + q) * 2 + 1] = pi;
    const float nre = ar - 1.f, nim = ai, den = 1.f / (are * are + aim * aim);
    const float cr = (nre * are + nim * aim) * den, ci = (nim * are - nre * aim) * den;
    const float* bre = p.in[16] + (size_t)gt * 16; const float* bim = p.in[17] + (size_t)gt * 16;
#pragma unroll
    for (int c = 0; c < 16; ++c) { const float br = bre[c], bi = bim[c];
        P[8192 + ((g * 16 + c) * 64 + q) * 2] = cr * br - ci * bi; P[8192 + ((g * 16 + c) * 64 + q) * 2 + 1] = cr * bi + ci * br; }
}

template <int MODE> __device__ __forceinline__ void norm_rows(const Params& p, LAS unsigned char* lds, const float* gain, int layer) {
    const int tid = threadIdx.x, lane = tid & 63, wid = tid >> 6;
    float* H = (float*)(p.ws + WS_H); bf16_t* XN = (bf16_t*)(p.ws + WS_XN);
    LAS float* wba = (LAS float*)lds;
    if (MODE == 1) {
        const float* win = p.in[7] + (size_t)layer * DM * INW;
        for (int i = tid; i < 2048; i += NTHR) { const int k = i >> 1, h = i & 1; const f32x4 v = *(const f32x4*)(win + (size_t)k * INW + 1792 + 4 * h);
            wba[k * 8 + 4 * h + 0] = v[0]; wba[k * 8 + 4 * h + 1] = v[1]; wba[k * 8 + 4 * h + 2] = v[2]; wba[k * 8 + 4 * h + 3] = v[3]; }
        __syncthreads();
    }
    for (int row = blockIdx.x * 8 + wid; row < MROWS; row += gridDim.x * 8) {
        const int b = row / LP, posb = row - b * LP;
        f32x4 v[4];
        if (MODE == 3) {
            const float* src = nullptr;
            if (posb >= 128) src = p.in[0] + ((size_t)b * SEQ + (posb - 128)) * DM; else if (posb >= PADF) src = p.in[1] + (size_t)(posb - PADF) * DM;
#pragma unroll
            for (int i = 0; i < 4; ++i) { v[i] = src ? *(const f32x4*)(src + (lane + 64 * i) * 4) : (f32x4){0.f, 0.f, 0.f, 0.f}; *(f32x4*)(H + (size_t)row * DM + (lane + 64 * i) * 4) = v[i]; }
        } else {
#pragma unroll
            for (int i = 0; i < 4; ++i) v[i] = *(const f32x4*)(H + (size_t)row * DM + (lane + 64 * i) * 4);
        }
        float ss = 0.f;
#pragma unroll
        for (int i = 0; i < 4; ++i) ss += v[i][0] * v[i][0] + v[i][1] * v[i][1] + v[i][2] * v[i][2] + v[i][3] * v[i][3];
#pragma unroll
        for (int d = 1; d < 64; d <<= 1) ss += __shfl_xor(ss, d);
        const float rstd = rsqrtf(ss * (1.f / 1024.f) + 1e-6f);
        float ba[8];
#pragma unroll
        for (int e = 0; e < 8; ++e) ba[e] = 0.f;
#pragma unroll
        for (int i = 0; i < 4; ++i) {
            const f32x4 g4 = *(const f32x4*)(gain + (lane + 64 * i) * 4);
            const f32x4 y = v[i] * g4 * rstd;
            if (MODE == 2) { if (posb >= 128) *(f32x4*)(p.out + ((size_t)b * SEQ + (posb - 128)) * DM + (lane + 64 * i) * 4) = y; }
            else { u32x2 w; w.x = pack2(y[0], y[1]); w.y = pack2(y[2], y[3]); *(u32x2*)(XN + (size_t)row * DM + (lane + 64 * i) * 4) = w; }
            if (MODE == 1) {
#pragma unroll
                for (int j = 0; j < 4; ++j) { const int k = (lane + 64 * i) * 4 + j;
#pragma unroll
                    for (int e = 0; e < 8; ++e) ba[e] += y[j] * wba[k * 8 + e]; }
            }
        }
        if (MODE == 1) {
#pragma unroll
            for (int e = 0; e < 8; ++e) {
#pragma unroll
                for (int d = 1; d < 64; d <<= 1) ba[e] += __shfl_xor(ba[e], d); }
            if (lane == 0) { float* o = (float*)(p.ws + WS_BA) + (size_t)row * 8;
#pragma unroll
                for (int e = 0; e < 8; ++e) o[e] = ba[e]; }
        }
    }
    if (MODE == 1) __syncthreads();
}

__device__ __forceinline__ void sb_item(LAS unsigned char* lds, int item, const bf16_t* proj, bf16_t* mixed, const float* gain) {
    const int tid = threadIdx.x, lane = tid & 63, wid = tid >> 6, fr = lane & 15, fq = lane >> 4;
    const int qb = item % NQB, bh = item / NQB, b = bh >> 2, hd = bh & 3;
    LAS bf16_t* Qs = (LAS bf16_t*)lds;
    LAS bf16_t* Ks = Qs + 128 * 72;
    LAS bf16_t* Vt = Ks + 128 * 72;
    LAS bf16_t* Ps = Vt + 64 * 136 + wid * (16 * 136);
    const size_t rowbase = (size_t)b * LP;
    { const int r = tid >> 2, seg = tid & 3;
      const bf16_t* src = proj + (rowbase + (size_t)qb * 128 + r) * PW + hd * 64 + seg * 16;
      const u32x4 v0 = *(const u32x4*)src, v1 = *(const u32x4*)(src + 8);
      *(LAS u32x4*)(Qs + r * 72 + seg * 16) = v0; *(LAS u32x4*)(Qs + r * 72 + seg * 16 + 8) = v1; }
    f32x4 o[4];
#pragma unroll
    for (int i = 0; i < 4; ++i) o[i] = (f32x4){0.f, 0.f, 0.f, 0.f};
    float carry[4] = {0.f, 0.f, 0.f, 0.f};
    bf16x8 qa[2];
    for (int kb = qb; kb >= 0; --kb) {
        { const int r = tid >> 2, seg = tid & 3;
          const bf16_t* srck = proj + (rowbase + (size_t)kb * 128 + r) * PW + 256 + hd * 64 + seg * 16;
          const u32x4 k0 = *(const u32x4*)srck, k1 = *(const u32x4*)(srck + 8);
          const u32x4 v0 = *(const u32x4*)(srck + 256), v1 = *(const u32x4*)(srck + 264);
          *(LAS u32x4*)(Ks + r * 72 + seg * 16) = k0; *(LAS u32x4*)(Ks + r * 72 + seg * 16 + 8) = k1;
          LAS bf16_t* vt = Vt + (seg * 16) * 136 + r;
          vt[0 * 136] = (bf16_t)(v0.x & 0xffff); vt[1 * 136] = (bf16_t)(v0.x >> 16); vt[2 * 136] = (bf16_t)(v0.y & 0xffff); vt[3 * 136] = (bf16_t)(v0.y >> 16);
          vt[4 * 136] = (bf16_t)(v0.z & 0xffff); vt[5 * 136] = (bf16_t)(v0.z >> 16); vt[6 * 136] = (bf16_t)(v0.w & 0xffff); vt[7 * 136] = (bf16_t)(v0.w >> 16);
          vt[8 * 136] = (bf16_t)(v1.x & 0xffff); vt[9 * 136] = (bf16_t)(v1.x >> 16); vt[10 * 136] = (bf16_t)(v1.y & 0xffff); vt[11 * 136] = (bf16_t)(v1.y >> 16);
          vt[12 * 136] = (bf16_t)(v1.z & 0xffff); vt[13 * 136] = (bf16_t)(v1.z >> 16); vt[14 * 136] = (bf16_t)(v1.w & 0xffff); vt[15 * 136] = (bf16_t)(v1.w >> 16); }
        __syncthreads();
        if (kb == qb) {
#pragma unroll
            for (int ks = 0; ks < 2; ++ks) qa[ks] = *(const LAS bf16x8*)(Qs + (wid * 16 + fr) * 72 + ks * 32 + fq * 8);
        }
        f32x4 z[8];
#pragma unroll
        for (int f = 0; f < 8; ++f) { z[f] = (f32x4){0.f, 0.f, 0.f, 0.f};
#pragma unroll
            for (int ks = 0; ks < 2; ++ks) { const bf16x8 kf = *(const LAS bf16x8*)(Ks + (f * 16 + fr) * 72 + ks * 32 + fq * 8); z[f] = mfma16(qa[ks], kf, z[f]); } }
        const int qpos0 = qb * 128 + wid * 16 + fq * 4;
        float lk[8][4];
#pragma unroll
        for (int f = 0; f < 8; ++f) { const int kpos = kb * 128 + f * 16 + fr;
#pragma unroll
            for (int r = 0; r < 4; ++r) { const bool valid = (kpos < qpos0 + r) && (kpos >= PADF);
                const float zs = z[f][r] * 0.125f; z[f][r] = zs; float v = valid ? -softplus_fast(zs) : 0.f;
#pragma unroll
                for (int d = 1; d < 16; d <<= 1) { const float t = __shfl_down(v, d, 16); v += (fr + d < 16) ? t : 0.f; }
                lk[f][r] = v; } }
#pragma unroll
        for (int r = 0; r < 4; ++r) { float run = carry[r];
#pragma unroll
            for (int f = 7; f >= 0; --f) { const int kpos = kb * 128 + f * 16 + fr; const bool valid = (kpos < qpos0 + r) && (kpos >= PADF);
                const float tot = __shfl(lk[f][r], 0, 16);
                const float w = valid ? __expf(z[f][r] + lk[f][r] + run) : 0.f;
                run += tot;
                Ps[(fq * 4 + r) * 136 + f * 16 + fr] = f2bf(w); }
            carry[r] = run; }
        WAVE_LDS_SYNC();
#pragma unroll
        for (int ks = 0; ks < 4; ++ks) { const bf16x8 pa = *(const LAS bf16x8*)(Ps + fr * 136 + ks * 32 + fq * 8);
#pragma unroll
            for (int df = 0; df < 4; ++df) { const bf16x8 vb = *(const LAS bf16x8*)(Vt + (df * 16 + fr) * 136 + ks * 32 + fq * 8); o[df] = mfma16(pa, vb, o[df]); } }
        const bool wdone = (carry[0] < -60.f) && (carry[1] < -60.f) && (carry[2] < -60.f) && (carry[3] < -60.f);
        const int cont = __syncthreads_or(wdone ? 0 : 1);
        if (!cont) break;
    }
#pragma unroll
    for (int r = 0; r < 4; ++r) { float ss = 0.f;
#pragma unroll
        for (int df = 0; df < 4; ++df) ss += o[df][r] * o[df][r];
#pragma unroll
        for (int d = 1; d < 16; d <<= 1) ss += __shfl_xor(ss, d, 16);
        const float rstd = rsqrtf(ss * (1.f / 64.f) + 1e-6f);
        bf16_t* dst = mixed + (rowbase + (size_t)qb * 128 + wid * 16 + fq * 4 + r) * DM + hd * 64;
#pragma unroll
        for (int df = 0; df < 4; ++df) dst[df * 16 + fr] = f2bf(o[df][r] * rstd * gain[df * 16 + fr]); }
}

struct DNBufs { bf16_t* W; bf16_t* QG; bf16_t* ATT; bf16_t* KT; bf16_t* UT; float* EGL; float* ODN; };
__device__ __forceinline__ DNBufs dn_bufs(const Params& p) {
    unsigned char* o = (unsigned char*)p.out;
    return DNBufs{(bf16_t*)(o + DO_W), (bf16_t*)(o + DO_QG), (bf16_t*)(o + DO_ATT), (bf16_t*)(o + DO_KT), (bf16_t*)(o + DO_UT), (float*)(o + DO_EGL), (float*)(o + DO_ODN)};
}
__device__ __forceinline__ void dn_local_item(const Params& p, LAS unsigned char* lds, int item, int layer, const bf16_t* proj, const DNBufs& D) {
    const int tid = threadIdx.x, lane = tid & 63, wid = tid >> 6, fr = lane & 15, fq = lane >> 4;
    const int n = item % NCH, bh = item / NCH, b = bh >> 2, hd = bh & 3;
    LAS float* Qf = (LAS float*)lds;
    LAS float* Kf = Qf + 64 * 65;
    LAS float* Vf = Kf + 64 * 65;
    LAS float* Lm = Vf + 64 * 65;
    LAS float* gcs = Lm + 64 * 68;
    LAS float* bts = gcs + 64;
    LAS bf16_t* Qb = (LAS bf16_t*)(bts + 64);
    LAS bf16_t* Kb = Qb + 64 * 72;
    const float* cw = p.in[9] + (size_t)layer * 4 * 768;
    const size_t pos0 = (size_t)b * LP + (size_t)n * 64;
    for (int idx = tid; idx < 64 * 192; idx += NTHR) {
        const int r = idx / 192, cc = idx - r * 192, which = cc >> 6, d = cc & 63, ch = which * 256 + hd * 64 + d;
        float val = 0.f;
        if (n * 64 + r >= PADF) {
            const bf16_t* src = proj + (pos0 + r - 3) * PW + 768 + ch;
            float a = 0.f;
#pragma unroll
            for (int j = 0; j < 4; ++j) a += cw[j * 768 + ch] * bf2f(src[(size_t)j * PW]);
            val = silu_fast(a);
        }
        (which == 0 ? Qf : (which == 1 ? Kf : Vf))[r * 65 + d] = val;
    }
    if (tid < 64) {
        const int posb = n * 64 + tid; float g = 0.f, bt = 0.f;
        if (posb >= PADF) { const float* bar = (const float*)(p.ws + WS_BA) + (pos0 + tid) * 8;
            bt = 1.f / (1.f + expf(-bar[hd]));
            const float x = bar[4 + hd] + p.in[11][layer * 4 + hd];
            g = -expf(p.in[10][layer * 4 + hd]) * (fmaxf(x, 0.f) + log1pf(expf(-fabsf(x)))); }
        float c = g;
#pragma unroll
        for (int d = 1; d < 64; d <<= 1) { const float t = __shfl_up(c, d); if (lane >= d) c += t; }
        gcs[tid] = c; bts[tid] = bt;
    }
    __syncthreads();
    if (tid < 128) {
        const int r = tid & 63; LAS float* X = (tid >> 6) ? Kf : Qf; LAS bf16_t* Xb = (tid >> 6) ? Kb : Qb;
        float ss = 0.f;
        for (int d = 0; d < 64; ++d) { const float x = X[r * 65 + d]; ss += x * x; }
        const float rs = rsqrtf(ss + 1e-6f);
        for (int d = 0; d < 64; ++d) { const float x = X[r * 65 + d] * rs; X[r * 65 + d] = x; Xb[r * 72 + d] = f2bf(x); }
    }
    __syncthreads();
    const size_t ob = (size_t)item * 4096;
    const float glast = gcs[63];
    for (int idx = tid; idx < 4096; idx += NTHR) {
        const int hi = idx >> 6, lo = idx & 63;
        D.QG[ob + idx] = f2bf(Qf[hi * 65 + lo] * 0.125f * __expf(gcs[hi]));
        D.KT[ob + idx] = f2bf(Kf[lo * 65 + hi] * __expf(glast - gcs[lo]));
    }
    if (tid == 0) D.EGL[item] = __expf(glast);
#pragma unroll
    for (int q4 = 0; q4 < 4; ++q4) {
        const int fid = wid * 4 + q4, gram = fid >> 4, fi = (fid >> 2) & 3, fj = fid & 3;
        LAS bf16_t* X = gram ? Qb : Kb;
        f32x4 acc = (f32x4){0.f, 0.f, 0.f, 0.f};
#pragma unroll
        for (int ks = 0; ks < 2; ++ks) { const bf16x8 a = *(const LAS bf16x8*)(X + (fi * 16 + fr) * 72 + ks * 32 + fq * 8);
            const bf16x8 bb = *(const LAS bf16x8*)(Kb + (fj * 16 + fr) * 72 + ks * 32 + fq * 8); acc = mfma16(a, bb, acc); }
        const int j = fj * 16 + fr; const float gj = gcs[j];
#pragma unroll
        for (int r = 0; r < 4; ++r) { const int i = fi * 16 + fq * 4 + r;
            const float dec = (i >= j) ? __expf(gcs[i] - gj) : 0.f;
            if (gram == 0) Lm[i * 68 + j] = (i > j) ? bts[i] * acc[r] * dec : 0.f;
            else D.ATT[ob + i * 64 + j] = f2bf(acc[r] * 0.125f * dec); }
    }
    __syncthreads();
    if (tid < 128) {
        const int col = tid & 63; const bool isw = tid >= 64;
        LAS float* X = isw ? Kf : Vf;
        for (int i = 0; i < 64; ++i) {
            float s = X[i * 65 + col] * bts[i] * (isw ? __expf(gcs[i]) : 1.f);
            for (int j = 0; j < i; ++j) s -= Lm[i * 68 + j] * X[j * 65 + col];
            X[i * 65 + col] = s;
        }
        if (isw) {
            for (int i = 0; i < 64; ++i) D.W[ob + i * 64 + col] = f2bf(X[i * 65 + col]);
        } else {
            for (int i8 = 0; i8 < 8; ++i8) { u32x4 w; w.x = pack2(X[(i8 * 8 + 0) * 65 + col], X[(i8 * 8 + 1) * 65 + col]); w.y = pack2(X[(i8 * 8 + 2) * 65 + col], X[(i8 * 8 + 3) * 65 + col]);
                w.z = pack2(X[(i8 * 8 + 4) * 65 + col], X[(i8 * 8 + 5) * 65 + col]); w.w = pack2(X[(i8 * 8 + 6) * 65 + col], X[(i8 * 8 + 7) * 65 + col]); *(u32x4*)(D.UT + ob + col * 64 + i8 * 8) = w; }
        }
    }
    __syncthreads();
}

__device__ __forceinline__ void dn_seq_block(LAS unsigned char* lds, int bh, const DNBufs& D) {
    const int tid = threadIdx.x, lane = tid & 63, wid = tid >> 6, fr = lane & 15, fq = lane >> 4;
    const int b = bh >> 2, hd = bh & 3, dvb = wid;
    constexpr int MATE = 64 * 72;
    constexpr int BUFE = 5 * MATE;
    LAS bf16_t* L0 = (LAS bf16_t*)lds;
    LAS bf16_t* STb = L0 + 2 * BUFE + wid * (2 * 16 * 72);
    LAS bf16_t* VNb = STb + 16 * 72;
    const int goff = tid * 8, loff = (tid >> 3) * 72 + (tid & 7) * 8;
    u32x4 r0, r1, r2, r3, r4; float egl_cur, egl_nxt;
#define DN_GLOAD(nq) do { const size_t ob_ = (size_t)(bh * NCH + (nq)) * 4096 + goff; r0 = *(const u32x4*)(D.W + ob_); r1 = *(const u32x4*)(D.QG + ob_); \
        r2 = *(const u32x4*)(D.ATT + ob_); r3 = *(const u32x4*)(D.KT + ob_); r4 = *(const u32x4*)(D.UT + ob_); } while (0)
#define DN_LSTORE(bq) do { LAS bf16_t* B_ = L0 + (bq) * BUFE + loff; *(LAS u32x4*)(B_) = r0; *(LAS u32x4*)(B_ + MATE) = r1; *(LAS u32x4*)(B_ + 2 * MATE) = r2; \
        *(LAS u32x4*)(B_ + 3 * MATE) = r3; *(LAS u32x4*)(B_ + 4 * MATE) = r4; } while (0)
    DN_GLOAD(0); DN_LSTORE(0); egl_cur = D.EGL[bh * NCH];
    __syncthreads();
    f32x4 ST[4];
#pragma unroll
    for (int f = 0; f < 4; ++f) ST[f] = (f32x4){0.f, 0.f, 0.f, 0.f};
    for (int n = 0; n < NCH; ++n) {
        const int nn = (n + 1 < NCH) ? n + 1 : n;
        DN_GLOAD(nn); egl_nxt = D.EGL[bh * NCH + nn];
        if (wid < 4) {
            const LAS bf16_t* Ws = L0 + (n & 1) * BUFE; const LAS bf16_t* QGs = Ws + MATE; const LAS bf16_t* ATs = Ws + 2 * MATE; const LAS bf16_t* KTs = Ws + 3 * MATE; const LAS bf16_t* UTs = Ws + 4 * MATE;
#pragma unroll
            for (int f = 0; f < 4; ++f)
#pragma unroll
                for (int r = 0; r < 4; ++r) STb[(fq * 4 + r) * 72 + f * 16 + fr] = f2bf(ST[f][r]);
            WAVE_LDS_SYNC();
            bf16x8 sa[2];
#pragma unroll
            for (int ks = 0; ks < 2; ++ks) sa[ks] = *(const LAS bf16x8*)(STb + fr * 72 + ks * 32 + fq * 8);
            f32x4 o[4];
#pragma unroll
            for (int cf = 0; cf < 4; ++cf) { f32x4 t = (f32x4){0.f, 0.f, 0.f, 0.f};
#pragma unroll
                for (int ks = 0; ks < 2; ++ks) t = mfma16(sa[ks], *(const LAS bf16x8*)(Ws + (cf * 16 + fr) * 72 + ks * 32 + fq * 8), t);
#pragma unroll
                for (int r = 0; r < 4; ++r) VNb[(fq * 4 + r) * 72 + cf * 16 + fr] = f2bf(bf2f(UTs[(dvb * 16 + fq * 4 + r) * 72 + cf * 16 + fr]) - t[r]);
                o[cf] = (f32x4){0.f, 0.f, 0.f, 0.f};
#pragma unroll
                for (int ks = 0; ks < 2; ++ks) o[cf] = mfma16(sa[ks], *(const LAS bf16x8*)(QGs + (cf * 16 + fr) * 72 + ks * 32 + fq * 8), o[cf]); }
            WAVE_LDS_SYNC();
            bf16x8 va[2];
#pragma unroll
            for (int ks = 0; ks < 2; ++ks) va[ks] = *(const LAS bf16x8*)(VNb + fr * 72 + ks * 32 + fq * 8);
#pragma unroll
            for (int cf = 0; cf < 4; ++cf)
#pragma unroll
                for (int ks = 0; ks < 2; ++ks) o[cf] = mfma16(va[ks], *(const LAS bf16x8*)(ATs + (cf * 16 + fr) * 72 + ks * 32 + fq * 8), o[cf]);
#pragma unroll
            for (int f = 0; f < 4; ++f) { ST[f] = ST[f] * egl_cur;
#pragma unroll
                for (int ks = 0; ks < 2; ++ks) ST[f] = mfma16(va[ks], *(const LAS bf16x8*)(KTs + (f * 16 + fr) * 72 + ks * 32 + fq * 8), ST[f]); }
#pragma unroll
            for (int cf = 0; cf < 4; ++cf) *(f32x4*)(D.ODN + ((size_t)b * LP + (size_t)n * 64 + cf * 16 + fr) * 256 + hd * 64 + dvb * 16 + fq * 4) = o[cf];
        }
        DN_LSTORE((n + 1) & 1);
        egl_cur = egl_nxt;
        __syncthreads();
    }
#undef DN_GLOAD
#undef DN_LSTORE
}

template <bool FINAL> __device__ __forceinline__ void s5_item(const Params& p, LAS unsigned char* ldsw, int item, int layer, const bf16_t* proj) {
    const int lane = threadIdx.x & 63, fr = lane & 15, fq = lane >> 4;
    const int g = item & 31, bn = item >> 5, n = bn % NCH, b = bn / NCH;
    LAS float* us = (LAS float*)ldsw;
    LAS bf16_t* Sb = (LAS bf16_t*)(us + 64 * 17);
    const size_t pos0 = (size_t)b * LP + (size_t)n * 64;
    { const bf16_t* src = proj + (pos0 + lane) * PW + 1792 + g * 16;
      const u32x4 v0 = *(const u32x4*)src, v1 = *(const u32x4*)(src + 8);
      LAS float* d = us + lane * 17;
      d[0] = bflo(v0.x); d[1] = bfhi(v0.x); d[2] = bflo(v0.y); d[3] = bfhi(v0.y); d[4] = bflo(v0.z); d[5] = bfhi(v0.z); d[6] = bflo(v0.w); d[7] = bfhi(v0.w);
      d[8] = bflo(v1.x); d[9] = bfhi(v1.x); d[10] = bflo(v1.y); d[11] = bfhi(v1.y); d[12] = bflo(v1.z); d[13] = bfhi(v1.z); d[14] = bflo(v1.w); d[15] = bfhi(v1.w); }
    const float* P = (const float*)(p.ws + WS_S5P) + (size_t)layer * S5P_L;
    const float ar = P[(g * 64 + lane) * 2], ai = P[(g * 64 + lane) * 2 + 1];
    float bre[16], bim[16];
#pragma unroll
    for (int c = 0; c < 16; ++c) { bre[c] = P[8192 + ((g * 16 + c) * 64 + lane) * 2]; bim[c] = P[8192 + ((g * 16 + c) * 64 + lane) * 2 + 1]; }
    float* E = (float*)(p.ws + WS_E);
    float sr = 0.f, si = 0.f;
    bf16x8 cmb[4]; float dd = 0.f;
    if (FINAL) {
        const float a64r = P[4096 + (g * 64 + lane) * 2], a64i = P[4096 + (g * 64 + lane) * 2 + 1];
        for (int m = 0; m < n; ++m) { const float* e = E + ((size_t)((b * NCH + m) * 32 + g) * 64 + lane) * 2; const float er = e[0], ei = e[1];
            const float nr = a64r * sr - a64i * si + er, ni = a64r * si + a64i * sr + ei; sr = nr; si = ni; }
        const float* cre = p.in[18] + ((size_t)(layer * 32 + g) * 16 + fr) * 64; const float* cim = p.in[19] + ((size_t)(layer * 32 + g) * 16 + fr) * 64;
#pragma unroll
        for (int kk = 0; kk < 4; ++kk) { bf16x8 t;
#pragma unroll
            for (int j = 0; j < 8; ++j) { const int k = (kk & 1) * 32 + fq * 8 + j; t[j] = (short)f2bf(kk < 2 ? cre[k] : -cim[k]); }
            cmb[kk] = t; }
        dd = p.in[20][layer * 512 + g * 16 + fr];
    }
    WAVE_LDS_SYNC();
    bf16_t* YG = (bf16_t*)(p.ws + WS_XN);
    for (int t = 0; t < 64; ++t) {
        float br = 0.f, bi = 0.f;
#pragma unroll
        for (int c = 0; c < 16; ++c) { const float u = us[t * 17 + c]; br += bre[c] * u; bi += bim[c] * u; }
        const float nr = ar * sr - ai * si + br, ni = ar * si + ai * sr + bi; sr = nr; si = ni;
        if (FINAL) {
            Sb[(t & 15) * 136 + lane] = f2bf(sr); Sb[(t & 15) * 136 + 64 + lane] = f2bf(si);
            if ((t & 15) == 15) {
                WAVE_LDS_SYNC();
                f32x4 y = (f32x4){0.f, 0.f, 0.f, 0.f};
#pragma unroll
                for (int kk = 0; kk < 4; ++kk) { const bf16x8 sa = *(const LAS bf16x8*)(Sb + fr * 136 + kk * 32 + fq * 8); y = mfma16(sa, cmb[kk], y); }
#pragma unroll
                for (int r = 0; r < 4; ++r) { const int tl = (t - 15) + fq * 4 + r;
                    const float yv = y[r] + dd * us[tl * 17 + fr];
                    const float x = 0.7978845608f * (yv + 0.044715f * yv * yv * yv);
                    const float th = 1.f - 2.f / (1.f + __expf(2.f * x));
                    YG[(pos0 + tl) * 512 + g * 16 + fr] = f2bf(0.5f * yv * (1.f + th)); }
                WAVE_LDS_SYNC();
            }
        }
    }
    if (!FINAL) { float* e = E + ((size_t)((b * NCH + n) * 32 + g) * 64 + lane) * 2; e[0] = sr; e[1] = si; }
}

__device__ __forceinline__ void mix_finalize(const Params& p, int layer, const bf16_t* proj, bf16_t* mixed) {
    const int lane = threadIdx.x & 63, wid = threadIdx.x >> 6;
    const float* odn = (const float*)((unsigned char*)p.out + DO_ODN);
    const bf16_t* GL = (const bf16_t*)(p.ws + WS_XN) + (size_t)MROWS * 512;
    const float* gdn = p.in[12] + layer * 64; const float* gs5 = p.in[23] + layer * 512;
    for (int row = blockIdx.x * 8 + wid; row < MROWS; row += gridDim.x * 8) {
        { const f32x4 v = *(const f32x4*)(odn + (size_t)row * 256 + lane * 4);
          float ss = v[0] * v[0] + v[1] * v[1] + v[2] * v[2] + v[3] * v[3];
#pragma unroll
          for (int d = 1; d < 16; d <<= 1) ss += __shfl_xor(ss, d, 16);
          const float rstd = rsqrtf(ss * (1.f / 64.f) + 1e-6f);
          const u32x2 zz = *(const u32x2*)(proj + (size_t)row * PW + 1536 + lane * 4);
          const f32x4 gg = *(const f32x4*)(gdn + (lane & 15) * 4);
          u32x2 w; w.x = pack2(v[0] * rstd * gg[0] * silu_fast(bflo(zz.x)), v[1] * rstd * gg[1] * silu_fast(bfhi(zz.x)));
          w.y = pack2(v[2] * rstd * gg[2] * silu_fast(bflo(zz.y)), v[3] * rstd * gg[3] * silu_fast(bfhi(zz.y)));
          *(u32x2*)(mixed + (size_t)row * DM + 256 + lane * 4) = w; }
        { const u32x4 gv = *(const u32x4*)(GL + (size_t)row * 512 + lane * 8);
          float v[8] = {bflo(gv.x), bfhi(gv.x), bflo(gv.y), bfhi(gv.y), bflo(gv.z), bfhi(gv.z), bflo(gv.w), bfhi(gv.w)};
          float ss = 0.f;
#pragma unroll
          for (int j = 0; j < 8; ++j) ss += v[j] * v[j];
#pragma unroll
          for (int d = 1; d < 64; d <<= 1) ss += __shfl_xor(ss, d);
          const float rstd = rsqrtf(ss * (1.f / 512.f) + 1e-6f);
          const f32x4 g0 = *(const f32x4*)(gs5 + lane * 8), g1 = *(const f32x4*)(gs5 + lane * 8 + 4);
          u32x4 w; w.x = pack2(v[0] * rstd * g0[0], v[1] * rstd * g0[1]); w.y = pack2(v[2] * rstd * g0[2], v[3] * rstd * g0[3]);
          w.z = pack2(v[4] * rstd * g1[0], v[5] * rstd * g1[1]); w.w = pack2(v[6] * rstd * g1[2], v[7] * rstd * g1[3]);
          *(u32x4*)(mixed + (size_t)row * DM + 512 + lane * 8) = w; }
    }
}

constexpr int NPHASE = 27;
__host__ __device__ inline int phase_kind(int ph) {
    if (ph == 0) return 0;
    const int l = (ph - 1) / 13, s = (ph - 1) % 13;
    switch (s) { case 2: return 2; case 4: return 3; case 5: return 4; case 7: return 5; case 9: return 6; case 12: return l == 0 ? 6 : 7; default: return 1; }
}
template <int KIND> __device__ __forceinline__ void phase_body(const Params& p, LAS unsigned char* lds, int ph) {
    const int wid = threadIdx.x >> 6;
    float* H = (float*)(p.ws + WS_H);
    bf16_t* XN = (bf16_t*)(p.ws + WS_XN);
    bf16_t* ACT = (bf16_t*)(p.ws + WS_BIG);
    bf16_t* PROJ = (bf16_t*)(p.ws + WS_BIG);
    bf16_t* MIXED = (bf16_t*)(p.ws + WS_BIG + SZ_PROJ);
    bf16_t* YG = XN; bf16_t* GL = XN + (size_t)MROWS * 512;
    const int l = ph == 0 ? 0 : (ph - 1) / 13, s = ph == 0 ? -1 : (ph - 1) % 13;
    const bf16_t* Wl = (const bf16_t*)(p.ws + WS_W) + (size_t)l * WL;
    if constexpr (KIND == 0) { convert_weights(p, lds); s5_params(p); norm_rows<3>(p, lds, p.in[2], 0); }
    if constexpr (KIND == 1) {
        EpiGen E; const bf16_t* A; const bf16_t* Bt; int N, K;
        E.Y = YG; E.bias = p.in[22] + l * 512; E.scale = 0.5f; E.ldc = PW;
        if (s == 0)       { E.mode = 0; E.O = ACT;   A = XN;    Bt = Wl + WO_GU1; N = 2 * DFF; K = DM; }
        else if (s == 1)  { E.mode = 1; E.O = H;     A = ACT;   Bt = Wl + WO_D1;  N = DM;      K = DFF; }
        else if (s == 3)  { E.mode = 2; E.O = PROJ;  A = XN;    Bt = Wl + WO_IN;  N = PW;      K = DM; }
        else if (s == 6)  { E.mode = 3; E.O = GL;    A = YG;    Bt = Wl + WO_GLU; N = 512;     K = 512; }
        else if (s == 8)  { E.mode = 1; E.O = H;     A = MIXED; Bt = Wl + WO_OUT; N = DM;      K = DM; E.scale = 1.0f; }
        else if (s == 10) { E.mode = 0; E.O = ACT;   A = XN;    Bt = Wl + WO_GU2; N = 2 * DFF; K = DM; }
        else              { E.mode = 1; E.O = H;     A = ACT;   Bt = Wl + WO_D2;  N = DM;      K = DFF; }
        run_gemm(lds, A, Bt, N, K, E);
    }
    if constexpr (KIND == 2) norm_rows<1>(p, lds, p.in[6] + l * DM, l);
    if constexpr (KIND == 3) {
        const DNBufs D = dn_bufs(p);
        for (int it = blockIdx.x; it < NDN; it += gridDim.x) dn_local_item(p, lds, it, l, PROJ, D);
        for (int it = blockIdx.x; it < 8 * NQB; it += gridDim.x) sb_item(lds, it, PROJ, MIXED, p.in[8] + l * 64);
        for (int it = blockIdx.x; it < NDN; it += gridDim.x) s5_item<false>(p, lds + wid * 8704, it * 8 + wid, l, PROJ);
    }
    if constexpr (KIND == 4) {
        const DNBufs D = dn_bufs(p);
        if (blockIdx.x < 8) dn_seq_block(lds, blockIdx.x, D);
        else { for (int it = blockIdx.x - 8; it < NDN; it += gridDim.x - 8) s5_item<true>(p, lds + wid * 8704, it * 8 + wid, l, PROJ); }
    }
    if constexpr (KIND == 5) mix_finalize(p, l, PROJ, MIXED);
    if constexpr (KIND == 6) norm_rows<0>(p, lds, (s == 9 ? p.in[25] + l * DM : p.in[2] + DM), l);
    if constexpr (KIND == 7) norm_rows<2>(p, lds, p.in[29], 1);
}
template <int KIND> __global__ void __launch_bounds__(NTHR, 2) k_phase(Params p) {
    extern __shared__ __attribute__((aligned(16))) unsigned char smem[];
    phase_body<KIND>(p, (LAS unsigned char*)smem, p.ph_lo);
}
template <int KIND> static void launch_phase(const Params& p, int grid, hipStream_t stream) {
    static bool attr = false;
    if (!attr) { (void)hipFuncSetAttribute((const void*)k_phase<KIND>, hipFuncAttributeMaxDynamicSharedMemorySize, LDS_BYTES); attr = true; }
    hipLaunchKernelGGL(k_phase<KIND>, dim3(grid), dim3(NTHR), LDS_BYTES, stream, p);
}

extern "C" void kernel_launch(void* const* d_in, const int* in_sizes, int n_in, void* d_out, int out_size, void* d_ws, size_t ws_size, hipStream_t stream) {
    static int grid = 0;
    if (grid == 0) {
        if (n_in != 30 || ws_size < WS_END) { fprintf(stderr, "kernel_launch: unexpected n_in %d or ws_size %zu (need %zu)\n", n_in, ws_size, (size_t)WS_END); grid = -1; return; }
        int dev = 0, cus = 0;
        (void)hipGetDevice(&dev);
        (void)hipDeviceGetAttribute(&cus, hipDeviceAttributeMultiprocessorCount, dev);
        grid = cus > 0 ? cus : 256;
    }
    if (grid < 0) return;
    Params p{};
    for (int i = 0; i < 30; ++i) p.in[i] = (const float*)d_in[i];
    p.out = (float*)d_out; p.ws = (unsigned char*)d_ws;
    for (int ph = 0; ph < NPHASE; ++ph) {
        p.ph_lo = ph; p.ph_hi = ph + 1;
        switch (phase_kind(ph)) {
        case 0: launch_phase<0>(p, grid, stream); break; case 1: launch_phase<1>(p, grid, stream); break;
        case 2: launch_phase<2>(p, grid, stream); break; case 3: launch_phase<3>(p, grid, stream); break;
        case 4: launch_phase<4>(p, grid, stream); break; case 5: launch_phase<5>(p, grid, stream); break;
        case 6: launch_phase<6>(p, grid, stream); break; default: launch_phase<7>(p, grid, stream); break;
        }
    }
}
```

```cpp
#include <hip/hip_runtime.h>
#include <hip/hip_cooperative_groups.h>
#include <cstdio>
namespace cg = cooperative_groups;

#ifndef SINGLE_LAUNCH
#define SINGLE_LAUNCH 1
#endif

__device__ __forceinline__ int otid() { int t = threadIdx.x; asm volatile("" : "+v"(t)); return t; }
__device__ __forceinline__ int obid() { int b = blockIdx.x; asm volatile("" : "+s"(b)); return b; }
namespace pg8 {
#define PG8_LAS __attribute__((address_space(3)))
typedef unsigned short bf16_t;
typedef short bf16x8 __attribute__((ext_vector_type(8)));
typedef float f32x4 __attribute__((ext_vector_type(4)));
typedef unsigned u32x4 __attribute__((ext_vector_type(4)));
constexpr int BM = 256, BK = 64, HALF = 128, HTB = HALF * BK * 2  , STAGE_BYTES = 8 * HTB, NXCD = 8, WGM = 4;

__host__ __device__ __forceinline__ int lds_byte(int r, int c) { const int st = (r >> 4) * 2 + (c >> 5), rr = r & 15, cc = c & 31, ob = rr * 64 + cc * 2; return st * 1024 + (ob ^ (((ob >> 9) & 1) << 5)); }
__host__ __device__ __forceinline__ void stage_rc(int b, int& R, int& C) { const int st = b / 1024, sb = b % 1024, swz = sb ^ (((sb >> 9) & 1) << 5); R = (st >> 1) * 16 + swz / 64; C = (st & 1) * 32 + (swz % 64) / 2; }
__host__ __device__ __forceinline__ int perm32(int rho) { const int n = rho >> 4, i = rho & 15; return 8 * (i >> 2) + 4 * n + (i & 3); }

struct Unit { int pm, pn, kp; };
struct Gemm { const bf16_t* A; const bf16_t* Bt; int M, N, K, ld; };

struct StaticOrder {
    int nM, nN, nwg, G, c;
    __host__ __device__ void init(int M, int N, int G_, int c_) { nM = M / BM; nN = N / BM; nwg = nM * nN; G = G_; c = c_; }
    __host__ __device__ bool next(int i, Unit& u) const {
        const long L = (long)i * G + c; if (L >= nwg) return false;
        int wgid = (int)L; { const int q = nwg / NXCD, r = nwg % NXCD, xcd = wgid % NXCD, off = wgid / NXCD; wgid = (xcd < r ? xcd * (q + 1) : r * (q + 1) + (xcd - r) * q) + off; }
        const int nig = WGM * nN, gid = wgid / nig, fm = gid * WGM, gsz = (nM - fm) < WGM ? (nM - fm) : WGM;
        u.pm = fm + ((wgid % nig) % gsz); u.pn = (wgid % nig) / gsz; u.kp = 0; return true;
    }
    __device__ __forceinline__ void a_ready(const Unit&) const {}
    __device__ __forceinline__ void done(const Unit&) const {}
};
struct HeadOrder : StaticOrder {
    int nfull;
    __host__ __device__ void init2(int M, int N, int G_, int c_) { init(M, N, G_, c_); nfull = (nwg / G_) * G_; }
    __host__ __device__ bool next(int i, Unit& u) const { if ((long)i * G + c >= nfull) return false; return StaticOrder::next(i, u); }
};
struct TailOrder : StaticOrder {
    int nfull, np;
    __host__ __device__ void init2(int M, int N, int G_, int c_, int np_) { init(M, N, G_, c_); nfull = (nwg / G_) * G_; np = np_; }
    __host__ __device__ bool next(int i, Unit& u) const {
        if (i > 0) return false;
        const int t = nfull + c / np; if (t >= nwg) return false;
        StaticOrder s2 = *this; s2.c = t % G; if (!s2.StaticOrder::next(t / G, u)) return false;
        u.kp = c % np; return true;
    }
};
__device__ __forceinline__ unsigned cvt_pk_bf16(float lo, float hi) { unsigned r; asm volatile("v_cvt_pk_bf16_f32 %0, %1, %2" : "=v"(r) : "v"(lo), "v"(hi)); return r; }
template <class Epi, class Sched, bool STAMP = false>
__device__ __forceinline__ void gemm_phase(PG8_LAS unsigned char* lds, const Gemm g, const Sched& S, const Epi& E, unsigned long long* stamps) {
    const int tid = otid(), wid = __builtin_amdgcn_readfirstlane(tid >> 6), lane = tid & 63, wr = wid >> 2, wc = wid & 3, fr = lane & 15, fq = lane >> 4;
    const int K = g.K, nt = K / BK, ld = g.ld;
    unsigned voffA[2], voffB[2];
#pragma unroll
    for (int i = 0; i < 2; ++i) { int R, C; stage_rc(tid * 16 + i * 8192, R, C); const int Rb = E.perm() ? ((R & ~31) + perm32(R & 31)) : R;
        voffA[i] = (unsigned)(R * ld + C) * 2u; voffB[i] = (unsigned)(Rb * ld + C) * 2u; }
    const size_t kstep = (size_t)(BK * 2);
    const size_t hstep = (size_t)HALF * ld * 2;
    const size_t tstep = 2 * hstep;
    const unsigned ldsw = (unsigned)wid * 1024u;
    const int aoff = lds_byte(wr * 64 + fr, fq * 8), boff = lds_byte(wc * 32 + fr, fq * 8);
#define PG8_SA(b, h) (((b) * 2 + (h)) * HTB)
#define PG8_SB(b, h) ((4 + (b) * 2 + (h)) * HTB)
#define PG8_STAGE(bufoff, gbase, voff) do { _Pragma("unroll") for (int _i = 0; _i < 2; ++_i) \
        __builtin_amdgcn_global_load_lds((const unsigned*)((const char*)(gbase) + (voff)[_i]), (PG8_LAS unsigned*)(lds + (bufoff) + ldsw + _i * 8192), 16, 0, 0); } while (0)
#define PG8_LDA(dst, b, h) do { _Pragma("unroll") for (int m = 0; m < 4; ++m) _Pragma("unroll") for (int k = 0; k < 2; ++k) dst[m][k] = *(const PG8_LAS bf16x8*)(lds + PG8_SA(b, h) + aoff + m * 2048 + k * 1024); } while (0)
#define PG8_LDB(dst, b, h) do { _Pragma("unroll") for (int n = 0; n < 2; ++n) _Pragma("unroll") for (int k = 0; k < 2; ++k) dst[n][k] = *(const PG8_LAS bf16x8*)(lds + PG8_SB(b, h) + boff + n * 2048 + k * 1024); } while (0)
#define PG8_MMA(ai, bj, At, Bt) do { __builtin_amdgcn_s_setprio(1); _Pragma("unroll") for (int m = 0; m < 4; ++m) _Pragma("unroll") for (int n = 0; n < 2; ++n) _Pragma("unroll") for (int k = 0; k < 2; ++k) \
        acc[ai][bj][m][n] = __builtin_amdgcn_mfma_f32_16x16x32_bf16(Bt[n][k], At[m][k], acc[ai][bj][m][n], 0, 0, 0); __builtin_amdgcn_s_setprio(0); } while (0)
#define PG8_WAIT_V(n) asm volatile("s_waitcnt vmcnt(" #n ")" ::: "memory")
#define PG8_WAIT_L(n) asm volatile("s_waitcnt lgkmcnt(" #n ")" ::: "memory")
#define PG8_BAR __builtin_amdgcn_s_barrier()
#define PG8_SCHED __builtin_amdgcn_sched_barrier(0)
    Unit cur, nxt; int ui = 0;
    if (!S.next(0, cur)) return;
    f32x4 acc[2][2][4][2];
#pragma unroll
    for (int a = 0; a < 2; ++a)
#pragma unroll
        for (int b = 0; b < 2; ++b)
#pragma unroll
            for (int m = 0; m < 4; ++m)
#pragma unroll
                for (int n = 0; n < 2; ++n) acc[a][b][m][n] = (f32x4){0.f, 0.f, 0.f, 0.f};
    bf16x8 At[4][2], B0[2][2], B1[2][2];
    const char* cA = (const char*)g.A + (size_t)cur.pm * tstep + (size_t)cur.kp * K * 2; const char* cB = (const char*)g.Bt + (size_t)cur.pn * tstep + (size_t)cur.kp * K * 2;
    S.a_ready(cur);
    PG8_STAGE(PG8_SB(0, 0), cB, voffB); PG8_STAGE(PG8_SA(0, 0), cA, voffA); PG8_STAGE(PG8_SB(0, 1), cB + hstep, voffB); PG8_STAGE(PG8_SA(0, 1), cA + hstep, voffA);
    if (wr == 1) PG8_BAR;
    PG8_WAIT_V(4); PG8_BAR;
    PG8_STAGE(PG8_SB(1, 0), cB + kstep, voffB); PG8_STAGE(PG8_SA(1, 0), cA + kstep, voffA); PG8_STAGE(PG8_SB(1, 1), cB + hstep + kstep, voffB);
    PG8_WAIT_V(6); PG8_BAR;
    for (;;) {
        const bool has_next = S.next(ui + 1, nxt);
        const char* nA = has_next ? (const char*)g.A + (size_t)nxt.pm * tstep + (size_t)nxt.kp * K * 2 : cA; const char* nB = has_next ? (const char*)g.Bt + (size_t)nxt.pn * tstep + (size_t)nxt.kp * K * 2 : cB;
        for (int t = 0; t < nt; t += 2) {
            const bool last = (t == nt - 2);
            const char* a1 = cA + (size_t)(t + 1) * kstep;
            const char* a2 = last ? nA : cA + (size_t)(t + 2) * kstep; const char* b2 = last ? nB : cB + (size_t)(t + 2) * kstep;
            const char* a3 = a2 + kstep; const char* b3 = b2 + kstep;
            if (last && has_next) S.a_ready(nxt);
            PG8_LDB(B0, 0, 0); PG8_SCHED; PG8_LDA(At, 0, 0); PG8_STAGE(PG8_SA(1, 1), a1 + hstep, voffA);
            PG8_WAIT_L(8); PG8_BAR; PG8_WAIT_L(0); PG8_MMA(0, 0, At, B0); PG8_BAR; PG8_SCHED;
            PG8_LDB(B1, 0, 1); PG8_STAGE(PG8_SB(0, 0), b2, voffB);
            PG8_BAR; PG8_WAIT_L(0); PG8_MMA(0, 1, At, B1); PG8_BAR;
            PG8_LDA(At, 0, 1); PG8_STAGE(PG8_SA(0, 0), a2, voffA);
            PG8_BAR; PG8_WAIT_L(0); PG8_MMA(1, 0, At, B0); PG8_BAR; PG8_SCHED;
            PG8_STAGE(PG8_SB(0, 1), b2 + hstep, voffB);
            PG8_WAIT_V(6); PG8_BAR; PG8_MMA(1, 1, At, B1); PG8_BAR;
            PG8_LDB(B0, 1, 0); PG8_SCHED; PG8_LDA(At, 1, 0); PG8_STAGE(PG8_SA(0, 1), a2 + hstep, voffA);
            PG8_WAIT_L(8); PG8_BAR; PG8_WAIT_L(0); PG8_MMA(0, 0, At, B0); PG8_BAR; PG8_SCHED;
            PG8_LDB(B1, 1, 1); PG8_STAGE(PG8_SB(1, 0), b3, voffB);
            PG8_BAR; PG8_WAIT_L(0); PG8_MMA(0, 1, At, B1); PG8_BAR;
            PG8_LDA(At, 1, 1); PG8_STAGE(PG8_SA(1, 0), a3, voffA);
            PG8_BAR; PG8_WAIT_L(0); PG8_MMA(1, 0, At, B0); PG8_BAR; PG8_SCHED;
            PG8_STAGE(PG8_SB(1, 1), b3 + hstep, voffB);
            PG8_WAIT_V(6); PG8_BAR; PG8_MMA(1, 1, At, B1); PG8_BAR;
        }
        if constexpr (!Epi::AFTER_DRAIN) { E(acc, cur, wr, wc, fr, fq); S.done(cur); }
        if (!has_next) break;
#pragma unroll
        for (int a = 0; a < 2; ++a)
#pragma unroll
            for (int b = 0; b < 2; ++b)
#pragma unroll
                for (int m = 0; m < 4; ++m)
#pragma unroll
                    for (int n = 0; n < 2; ++n) acc[a][b][m][n] = (f32x4){0.f, 0.f, 0.f, 0.f};
        cur = nxt; cA = nA; cB = nB; ++ui;
    }
    PG8_WAIT_V(0);
    if (wr == 0) PG8_BAR;
    PG8_BAR;
    if constexpr (Epi::AFTER_DRAIN) { E.fused(acc, cur, wr, wc, fr, fq, lds, wid, lane); S.done(cur); }
#undef PG8_SA
#undef PG8_SB
#undef PG8_STAGE
#undef PG8_LDA
#undef PG8_LDB
#undef PG8_MMA
#undef PG8_WAIT_V
#undef PG8_WAIT_L
#undef PG8_BAR
#undef PG8_SCHED
}
template <class Epi, class Sched, bool ALIGN_EPI = false, bool SP2 = false>
__device__ __forceinline__ void gemm_phase2(PG8_LAS unsigned char* lds, const Gemm g, const Sched& S, const Epi& E) {
    const int tid = otid(), wid = __builtin_amdgcn_readfirstlane(tid >> 6), lane = tid & 63, wr = wid >> 2, wc = wid & 3, fr = lane & 15, fq = lane >> 4;
    const int K = g.K, nt = K / BK, ld = g.ld;
    unsigned voffA[2], voffB[2];
#pragma unroll
    for (int i = 0; i < 2; ++i) { int R, C; stage_rc(tid * 16 + i * 8192, R, C); const int Rb = E.perm() ? ((R & ~31) + perm32(R & 31)) : R;
        voffA[i] = (unsigned)(R * ld + C) * 2u; voffB[i] = (unsigned)(Rb * ld + C) * 2u; }
    const size_t kstep = (size_t)(BK * 2);
    const size_t hstep = (size_t)HALF * ld * 2;
    const size_t tstep = 2 * hstep;
    const unsigned ldsw = (unsigned)wid * 1024u;
    const int aoff = lds_byte(wr * 64 + fr, fq * 8), boff = lds_byte(wc * 32 + fr, fq * 8);
#define PG8_SA(b, h) (((b) * 2 + (h)) * HTB)
#define PG8_SB(b, h) ((4 + (b) * 2 + (h)) * HTB)
#define PG8_STAGE(bufoff, gbase, voff) do { _Pragma("unroll") for (int _i = 0; _i < 2; ++_i) \
        __builtin_amdgcn_global_load_lds((const unsigned*)((const char*)(gbase) + (voff)[_i]), (PG8_LAS unsigned*)(lds + (bufoff) + ldsw + _i * 8192), 16, 0, 0); } while (0)
#define PG8_LDA(dst, b, h) do { _Pragma("unroll") for (int m = 0; m < 4; ++m) _Pragma("unroll") for (int k = 0; k < 2; ++k) dst[m][k] = *(const PG8_LAS bf16x8*)(lds + PG8_SA(b, h) + aoff + m * 2048 + k * 1024); } while (0)
#define PG8_LDB(dst, b, h) do { _Pragma("unroll") for (int n = 0; n < 2; ++n) _Pragma("unroll") for (int k = 0; k < 2; ++k) dst[n][k] = *(const PG8_LAS bf16x8*)(lds + PG8_SB(b, h) + boff + n * 2048 + k * 1024); } while (0)
#define PG8_MMA(ai, bj, At, Bt) do { __builtin_amdgcn_s_setprio(1); _Pragma("unroll") for (int m = 0; m < 4; ++m) _Pragma("unroll") for (int n = 0; n < 2; ++n) _Pragma("unroll") for (int k = 0; k < 2; ++k) \
        acc[ai][bj][m][n] = __builtin_amdgcn_mfma_f32_16x16x32_bf16(Bt[n][k], At[m][k], acc[ai][bj][m][n], 0, 0, 0); __builtin_amdgcn_s_setprio(0); } while (0)
#define PG8_WAIT_V(n) asm volatile("s_waitcnt vmcnt(" #n ")" ::: "memory")
#define PG8_WAIT_L(n) asm volatile("s_waitcnt lgkmcnt(" #n ")" ::: "memory")
#define PG8_BAR __builtin_amdgcn_s_barrier()
#define PG8_SCHED __builtin_amdgcn_sched_barrier(0)
    Unit cur, nxt; int ui = 0;
    if (!S.next(0, cur)) return;
    f32x4 acc[2][2][4][2];
#pragma unroll
    for (int a = 0; a < 2; ++a)
#pragma unroll
        for (int b = 0; b < 2; ++b)
#pragma unroll
            for (int m = 0; m < 4; ++m)
#pragma unroll
                for (int n = 0; n < 2; ++n) acc[a][b][m][n] = (f32x4){0.f, 0.f, 0.f, 0.f};
    bf16x8 At[4][2], B0[2][2], B1[2][2];
    const char* cA = (const char*)g.A + (size_t)cur.pm * tstep + (size_t)cur.kp * K * 2; const char* cB = (const char*)g.Bt + (size_t)cur.pn * tstep + (size_t)cur.kp * K * 2;
    S.a_ready(cur);
    if constexpr (SP2) {
        PG8_STAGE(PG8_SB(0, 0), cB, voffB); PG8_STAGE(PG8_SB(0, 1), cB + hstep, voffB); PG8_STAGE(PG8_SA(0, 0), cA, voffA); PG8_STAGE(PG8_SA(0, 1), cA + hstep, voffA);
        if (wr == 1) PG8_BAR;
        PG8_WAIT_V(2); PG8_BAR;
        PG8_STAGE(PG8_SB(1, 0), cB + kstep, voffB); PG8_STAGE(PG8_SA(1, 0), cA + kstep, voffA); PG8_STAGE(PG8_SB(1, 1), cB + hstep + kstep, voffB);
        PG8_WAIT_V(6); PG8_BAR;
    } else {
        PG8_STAGE(PG8_SB(0, 0), cB, voffB); PG8_STAGE(PG8_SA(0, 0), cA, voffA); PG8_STAGE(PG8_SB(0, 1), cB + hstep, voffB); PG8_STAGE(PG8_SA(0, 1), cA + hstep, voffA);
        if (wr == 1) PG8_BAR;
        PG8_WAIT_V(4); PG8_BAR;
        PG8_STAGE(PG8_SB(1, 0), cB + kstep, voffB); PG8_STAGE(PG8_SA(1, 0), cA + kstep, voffA); PG8_STAGE(PG8_SB(1, 1), cB + hstep + kstep, voffB);
        PG8_WAIT_V(6); PG8_BAR;
    }
    for (;;) {
        const bool has_next = S.next(ui + 1, nxt);
        const char* nA = has_next ? (const char*)g.A + (size_t)nxt.pm * tstep + (size_t)nxt.kp * K * 2 : cA; const char* nB = has_next ? (const char*)g.Bt + (size_t)nxt.pn * tstep + (size_t)nxt.kp * K * 2 : cB;
        for (int t = 0; t < nt; t += 2) {
            const bool last = (t == nt - 2);
            const char* a1 = cA + (size_t)(t + 1) * kstep;
            const char* a2 = last ? nA : cA + (size_t)(t + 2) * kstep; const char* b2 = last ? nB : cB + (size_t)(t + 2) * kstep;
            const char* a3 = a2 + kstep; const char* b3 = b2 + kstep;
            if (last && has_next) S.a_ready(nxt);
            if constexpr (SP2) {
            PG8_LDB(B0, 0, 0); PG8_LDB(B1, 0, 1); PG8_SCHED; PG8_LDA(At, 0, 0); PG8_STAGE(PG8_SA(1, 1), a1 + hstep, voffA);
            PG8_WAIT_V(8); PG8_WAIT_L(0); PG8_BAR; PG8_MMA(0, 0, At, B0); PG8_MMA(0, 1, At, B1); PG8_BAR; PG8_SCHED;
            PG8_LDA(At, 0, 1); PG8_STAGE(PG8_SB(0, 0), b2, voffB); PG8_STAGE(PG8_SB(0, 1), b2 + hstep, voffB); PG8_STAGE(PG8_SA(0, 0), a2, voffA);
            PG8_WAIT_V(8); PG8_WAIT_L(0); PG8_BAR; PG8_MMA(1, 0, At, B0); PG8_MMA(1, 1, At, B1); PG8_BAR; PG8_SCHED;
            PG8_LDB(B0, 1, 0); PG8_LDB(B1, 1, 1); PG8_SCHED; PG8_LDA(At, 1, 0); PG8_STAGE(PG8_SA(0, 1), a2 + hstep, voffA);
            PG8_WAIT_V(8); PG8_WAIT_L(0); PG8_BAR; PG8_MMA(0, 0, At, B0); PG8_MMA(0, 1, At, B1); PG8_BAR; PG8_SCHED;
            PG8_LDA(At, 1, 1); PG8_STAGE(PG8_SB(1, 0), b3, voffB); PG8_STAGE(PG8_SB(1, 1), b3 + hstep, voffB); PG8_STAGE(PG8_SA(1, 0), a3, voffA);
            PG8_WAIT_V(8); PG8_WAIT_L(0); PG8_BAR; PG8_MMA(1, 0, At, B0); PG8_MMA(1, 1, At, B1); PG8_BAR; PG8_SCHED;
            } else {
            PG8_LDB(B0, 0, 0); PG8_SCHED; PG8_LDA(At, 0, 0); PG8_STAGE(PG8_SA(1, 1), a1 + hstep, voffA);
            PG8_WAIT_L(8); PG8_BAR; PG8_WAIT_L(0); PG8_MMA(0, 0, At, B0); PG8_BAR; PG8_SCHED;
            PG8_LDB(B1, 0, 1); PG8_STAGE(PG8_SB(0, 0), b2, voffB);
            PG8_BAR; PG8_WAIT_L(0); PG8_MMA(0, 1, At, B1); PG8_BAR;
            PG8_LDA(At, 0, 1); PG8_STAGE(PG8_SA(0, 0), a2, voffA);
            PG8_BAR; PG8_WAIT_L(0); PG8_MMA(1, 0, At, B0); PG8_BAR; PG8_SCHED;
            PG8_STAGE(PG8_SB(0, 1), b2 + hstep, voffB);
            PG8_WAIT_V(6); PG8_BAR; PG8_MMA(1, 1, At, B1); PG8_BAR;
            PG8_LDB(B0, 1, 0); PG8_SCHED; PG8_LDA(At, 1, 0); PG8_STAGE(PG8_SA(0, 1), a2 + hstep, voffA);
            PG8_WAIT_L(8); PG8_BAR; PG8_WAIT_L(0); PG8_MMA(0, 0, At, B0); PG8_BAR; PG8_SCHED;
            PG8_LDB(B1, 1, 1); PG8_STAGE(PG8_SB(1, 0), b3, voffB);
            PG8_BAR; PG8_WAIT_L(0); PG8_MMA(0, 1, At, B1); PG8_BAR;
            PG8_LDA(At, 1, 1); PG8_STAGE(PG8_SA(1, 0), a3, voffA);
            PG8_BAR; PG8_WAIT_L(0); PG8_MMA(1, 0, At, B0); PG8_BAR; PG8_SCHED;
            PG8_STAGE(PG8_SB(1, 1), b3 + hstep, voffB);
            PG8_WAIT_V(6); PG8_BAR; PG8_MMA(1, 1, At, B1); PG8_BAR;
            }
        }
        if constexpr (ALIGN_EPI) { if (wr == 0) PG8_BAR; }
        if constexpr (!Epi::AFTER_DRAIN) { E(acc, cur, wr, wc, fr, fq); S.done(cur); }
        if (!has_next) break;
#pragma unroll
        for (int a = 0; a < 2; ++a)
#pragma unroll
            for (int b = 0; b < 2; ++b)
#pragma unroll
                for (int m = 0; m < 4; ++m)
#pragma unroll
                    for (int n = 0; n < 2; ++n) acc[a][b][m][n] = (f32x4){0.f, 0.f, 0.f, 0.f};
        cur = nxt; cA = nA; cB = nB; ++ui;
        if constexpr (ALIGN_EPI) { if (wr == 1) PG8_BAR; }
    }
    PG8_WAIT_V(0);
    if constexpr (!ALIGN_EPI) { if (wr == 0) PG8_BAR; }
    PG8_BAR;
    if constexpr (Epi::AFTER_DRAIN) { E.fused(acc, cur, wr, wc, fr, fq, lds, wid, lane); S.done(cur); }
#undef PG8_SA
#undef PG8_SB
#undef PG8_STAGE
#undef PG8_LDA
#undef PG8_LDB
#undef PG8_MMA
#undef PG8_WAIT_V
#undef PG8_WAIT_L
#undef PG8_BAR
#undef PG8_SCHED
}
}

#define LAS __attribute__((address_space(3)))
typedef unsigned short bf16_t;
typedef short bf16x8 __attribute__((ext_vector_type(8)));
typedef float f32x4 __attribute__((ext_vector_type(4)));
typedef unsigned u32x4 __attribute__((ext_vector_type(4)));
typedef unsigned u32x2 __attribute__((ext_vector_type(2)));

constexpr int DM = 1024, DFF = 2816, SEQ = 16384, PADF = 112, LP = 16512, MROWS = 33024, PW = 2304, INW = 2312;
constexpr int NCH = 258;
constexpr int NQB = 129;
constexpr int NTHR = 512;
constexpr int LDS_BYTES = 131072 + 16;

constexpr size_t WS_H = 0;
constexpr size_t SZ_H = (size_t)MROWS * DM * 4;
constexpr size_t WS_XN = WS_H + SZ_H;
constexpr size_t SZ_XN = (size_t)MROWS * DM * 2;
constexpr size_t WS_BIG = WS_XN + SZ_XN;
constexpr size_t SZ_PROJ = (size_t)MROWS * PW * 2;
constexpr size_t SZ_BIG = SZ_PROJ + SZ_XN;
constexpr size_t WS_W = WS_BIG + SZ_BIG;
constexpr size_t WL = 20971520;
constexpr size_t SZ_W = WL * 2 * 2;
constexpr size_t WS_BA = WS_W + SZ_W;
constexpr size_t SZ_BA = (size_t)MROWS * 8 * 4;
constexpr size_t WS_E = WS_BA + SZ_BA;
constexpr size_t SZ_E = (size_t)2 * NCH * 32 * 64 * 2 * 4;
constexpr size_t WS_S5P = WS_E + SZ_E;
constexpr size_t S5P_L = 73728;
constexpr size_t SZ_S5P = 2 * S5P_L * 4;
constexpr size_t WS_BAR = WS_S5P + SZ_S5P;
constexpr size_t SZ_BAR = 16384;
constexpr size_t WS_CIN = WS_BAR + SZ_BAR;
constexpr size_t WS_END = WS_CIN + SZ_E;
static_assert(WS_END <= 536870912ull, "workspace too large");
static_assert(SZ_BIG >= (size_t)MROWS * DFF * 2, "act must fit");
constexpr size_t WO_GU1 = 0, WO_D1 = 5767168, WO_IN = 8650752, WO_GLU = 11010048, WO_OUT = 11272192, WO_GU2 = 12320768, WO_D2 = 18087936;
constexpr int NDN = 8 * NCH;
constexpr size_t DO_W = 0, DO_QG = 16908288, DO_ATT = 2 * 16908288ull, DO_KT = 3 * 16908288ull, DO_UT = 4 * 16908288ull, DO_EGL = 5 * 16908288ull;
constexpr size_t DO_ODN = DO_EGL + 8448;
static_assert(DO_ODN + (size_t)MROWS * 256 * 4 <= 134217728ull, "d_out scratch too large");

template <class T> __device__ __forceinline__ T* as_global(T* q) {
#if defined(__HIP_DEVICE_COMPILE__)
    __builtin_assume(!__builtin_amdgcn_is_shared((const __attribute__((address_space(0))) void*)q)); __builtin_assume(!__builtin_amdgcn_is_private((const __attribute__((address_space(0))) void*)q));
#endif
    return q; }
#define GAS __attribute__((address_space(1)))
struct ParamsG { const GAS float* in[30]; GAS float* out; GAS unsigned char* ws; int ph_lo, ph_hi; };
struct Params { const float* in[30]; float* out; unsigned char* ws; int ph_lo, ph_hi; };

typedef float f32x2_t __attribute__((ext_vector_type(2)));
typedef __bf16 bf16x2_t __attribute__((ext_vector_type(2)));
__device__ __forceinline__ unsigned pack2(float lo, float hi) { const f32x2_t v = {lo, hi}; const bf16x2_t b = __builtin_convertvector(v, bf16x2_t); return __builtin_bit_cast(unsigned, b); }
__device__ __forceinline__ bf16_t f2bf(float f) { return (bf16_t)(pack2(f, 0.f) & 0xffffu); }
__device__ __forceinline__ float bf2f(bf16_t b) { return __uint_as_float(((unsigned)b) << 16); }
__device__ __forceinline__ float bflo(unsigned w) { return __uint_as_float(w << 16); }
__device__ __forceinline__ float bfhi(unsigned w) { return __uint_as_float(w & 0xffff0000u); }
__device__ __forceinline__ float softplus_fast(float x) { return fmaxf(x, 0.f) + __logf(1.f + __expf(-fabsf(x))); }
__device__ __forceinline__ float sigmoid_fast(float x) { return __builtin_amdgcn_rcpf(1.f + __expf(-x)); }
__device__ __forceinline__ float silu_fast(float x) { return x * __builtin_amdgcn_rcpf(1.f + __expf(-x)); }
__device__ __forceinline__ f32x4 mfma16(bf16x8 a, bf16x8 b, f32x4 c) { return __builtin_amdgcn_mfma_f32_16x16x32_bf16(a, b, c, 0, 0, 0); }
#define WAVE_LDS_SYNC() do { asm volatile("s_waitcnt lgkmcnt(0)" ::: "memory"); __builtin_amdgcn_wave_barrier(); } while (0)

#ifndef GEMM_SP2
#define GEMM_SP2 true
#endif
#ifndef ALIGN_RES
#define ALIGN_RES true
#endif
#ifndef GEMM_ALIGN
#define GEMM_ALIGN false
#endif
struct EpiSwiGLU {
    static constexpr bool PERM = true, AFTER_DRAIN = false; __device__ __forceinline__ constexpr bool perm() const { return true; }
    bf16_t* O;
    __device__ __forceinline__ void operator()(const f32x4 (&acc)[2][2][4][2], const pg8::Unit& u, int wr, int wc, int fr, int fq) const {
        const int row0 = u.pm * 256 + wr * 64 + fr, j0 = u.pn * 128 + wc * 32 + 8 * fq;
#pragma unroll
        for (int ai = 0; ai < 2; ++ai)
#pragma unroll
            for (int m = 0; m < 4; ++m) {
                const f32x4 g0 = acc[ai][0][m][0], g1 = acc[ai][0][m][1], u0 = acc[ai][1][m][0], u1 = acc[ai][1][m][1];
                u32x4 w;
                w.x = pack2(silu_fast(g0[0]) * u0[0], silu_fast(g0[1]) * u0[1]); w.y = pack2(silu_fast(g0[2]) * u0[2], silu_fast(g0[3]) * u0[3]);
                w.z = pack2(silu_fast(g1[0]) * u1[0], silu_fast(g1[1]) * u1[1]); w.w = pack2(silu_fast(g1[2]) * u1[2], silu_fast(g1[3]) * u1[3]);
                __builtin_nontemporal_store(w, (u32x4*)(O + (size_t)(row0 + ai * 128 + m * 16) * DFF + j0));
            }
    }
};
struct EpiResid {
    static constexpr bool PERM = false, AFTER_DRAIN = false; __device__ __forceinline__ constexpr bool perm() const { return false; }
    float* H; float scale; int atomic;
    __device__ __forceinline__ void operator()(const f32x4 (&acc)[2][2][4][2], const pg8::Unit& u, int wr, int wc, int fr, int fq) const {
        const int row0 = u.pm * 256 + wr * 64 + fr, col0 = u.pn * 256 + wc * 32 + 4 * fq;
#pragma unroll
        for (int ai = 0; ai < 2; ++ai)
#pragma unroll
            for (int m = 0; m < 4; ++m) { float* rowp = H + (size_t)(row0 + ai * 128 + m * 16) * DM + col0;
#pragma unroll
                for (int bj = 0; bj < 2; ++bj)
#pragma unroll
                    for (int n = 0; n < 2; ++n) { f32x4* q = (f32x4*)(rowp + bj * 128 + n * 16); const f32x4 v = acc[ai][bj][m][n] * scale;
                        if (atomic) { float* qf = (float*)q; unsafeAtomicAdd(qf, v[0]); unsafeAtomicAdd(qf + 1, v[1]); unsafeAtomicAdd(qf + 2, v[2]); unsafeAtomicAdd(qf + 3, v[3]); }
                        else *q = *q + v; } }
    }
};
struct EpiBf16 {
    static constexpr bool PERM = true, AFTER_DRAIN = false; __device__ __forceinline__ constexpr bool perm() const { return true; }
    bf16_t* O; int ldc;
    __device__ __forceinline__ void operator()(const f32x4 (&acc)[2][2][4][2], const pg8::Unit& u, int wr, int wc, int fr, int fq) const {
        const int row0 = u.pm * 256 + wr * 64 + fr, col0 = u.pn * 256 + wc * 32 + 8 * fq;
#pragma unroll
        for (int ai = 0; ai < 2; ++ai)
#pragma unroll
            for (int m = 0; m < 4; ++m) { bf16_t* rowp = O + (size_t)(row0 + ai * 128 + m * 16) * ldc + col0;
#pragma unroll
                for (int bj = 0; bj < 2; ++bj) { const f32x4 v0 = acc[ai][bj][m][0], v1 = acc[ai][bj][m][1];
                    u32x4 w; w.x = pack2(v0[0], v0[1]); w.y = pack2(v0[2], v0[3]); w.z = pack2(v1[0], v1[1]); w.w = pack2(v1[2], v1[3]);
                    *(u32x4*)(rowp + bj * 128) = w; } }
    }
};
struct EpiGLU {
    static constexpr bool PERM = true, AFTER_DRAIN = false; __device__ __forceinline__ constexpr bool perm() const { return true; }
    const bf16_t* Y; bf16_t* O; const float* bias;
    __device__ __forceinline__ void operator()(const f32x4 (&acc)[2][2][4][2], const pg8::Unit& u, int wr, int wc, int fr, int fq) const {
        const int row0 = u.pm * 256 + wr * 64 + fr, col0 = u.pn * 256 + wc * 32 + 8 * fq;
#pragma unroll
        for (int ai = 0; ai < 2; ++ai)
#pragma unroll
            for (int m = 0; m < 4; ++m) { const size_t ro = (size_t)(row0 + ai * 128 + m * 16) * 512 + col0;
#pragma unroll
                for (int bj = 0; bj < 2; ++bj) { const f32x4 v0 = acc[ai][bj][m][0], v1 = acc[ai][bj][m][1];
                    const u32x4 yv = *(const u32x4*)(Y + ro + bj * 128);
                    const f32x4 b0 = *(const f32x4*)(bias + col0 + bj * 128), b1 = *(const f32x4*)(bias + col0 + bj * 128 + 4);
                    u32x4 w;
                    w.x = pack2(bflo(yv.x) * sigmoid_fast(v0[0] + b0[0]), bfhi(yv.x) * sigmoid_fast(v0[1] + b0[1]));
                    w.y = pack2(bflo(yv.y) * sigmoid_fast(v0[2] + b0[2]), bfhi(yv.y) * sigmoid_fast(v0[3] + b0[3]));
                    w.z = pack2(bflo(yv.z) * sigmoid_fast(v1[0] + b1[0]), bfhi(yv.z) * sigmoid_fast(v1[1] + b1[1]));
                    w.w = pack2(bflo(yv.w) * sigmoid_fast(v1[2] + b1[2]), bfhi(yv.w) * sigmoid_fast(v1[3] + b1[3]));
                    *(u32x4*)(O + ro + bj * 128) = w; } }
    }
};
struct EpiGen {
    static constexpr bool AFTER_DRAIN = false;
    int mode;
    void* O; const bf16_t* Y; const float* bias; float scale; int ldc;
    __device__ __forceinline__ bool perm() const { return mode != 1; }
    __device__ __forceinline__ void operator()(const f32x4 (&acc)[2][2][4][2], const pg8::Unit& u, int wr, int wc, int fr, int fq) const {
        if (mode == 0) { EpiSwiGLU e{(bf16_t*)O}; e(acc, u, wr, wc, fr, fq); }
        else if (mode == 1) { EpiResid e{(float*)O, scale, 0}; e(acc, u, wr, wc, fr, fq); }
        else if (mode == 2) { EpiBf16 e{(bf16_t*)O, ldc}; e(acc, u, wr, wc, fr, fq); }
        else { EpiGLU e{Y, (bf16_t*)O, bias}; e(acc, u, wr, wc, fr, fq); }
    }
};
__device__ __forceinline__ void run_gemm(LAS unsigned char* lds, const bf16_t* A, const bf16_t* Bt, int N, int K, const EpiGen& E) {
    pg8::Gemm g{A, Bt, MROWS, N, K, K}; pg8::StaticOrder S; S.init(MROWS, N, (int)gridDim.x, obid());
    pg8::gemm_phase2<EpiGen, pg8::StaticOrder, GEMM_ALIGN, GEMM_SP2>(lds, g, S, E);
}

template <class Epi, bool ALIGN = GEMM_ALIGN> __device__ __forceinline__ void run_gemm(LAS unsigned char* lds, const bf16_t* A, const bf16_t* Bt, int N, int K, const Epi& E) {
    pg8::Gemm g{A, Bt, MROWS, N, K, K}; pg8::StaticOrder S; S.init(MROWS, N, (int)gridDim.x, obid());
    pg8::gemm_phase2<Epi, pg8::StaticOrder, ALIGN, GEMM_SP2>(lds, g, S, E);
}
__device__ __forceinline__ void run_gemm_resid(LAS unsigned char* lds, const bf16_t* A, const bf16_t* Bt, int N, int K, float* H, float scale) {
    { pg8::Gemm g{A, Bt, MROWS, N, K, K}; pg8::HeadOrder S; S.init2(MROWS, N, (int)gridDim.x, obid()); EpiResid E{H, scale, 0};
      pg8::gemm_phase2<EpiResid, pg8::HeadOrder, ALIGN_RES, GEMM_SP2>(lds, g, S, E); }
    { pg8::Gemm g{A, Bt, MROWS, N, 256, K}; pg8::TailOrder S; S.init2(MROWS, N, (int)gridDim.x, obid(), K / 256); EpiResid E{H, scale, 1};
      pg8::gemm_phase2<EpiResid, pg8::TailOrder, GEMM_ALIGN, GEMM_SP2>(lds, g, S, E); }
}
struct CvtTile { const float* src; bf16_t* dst; int ld_src, ld_dst; };
__device__ __forceinline__ CvtTile convert_desc(const Params& p, int t) {
        bf16_t* W = (bf16_t*)(p.ws + WS_W);
        const int l = t / 5120; int r = t % 5120;
        bf16_t* Wl = W + (size_t)l * WL;
        const float* src; int ld_src; bf16_t* dst; int ld_dst;
        if (r < 1408 || (r >= 3008 && r < 4416)) {
            const bool second = r >= 3008; if (second) r -= 3008;
            const int tn = r >> 4, tk = r & 15, n0 = tn * 64, pn = n0 >> 8, bj = (n0 >> 7) & 1, i0 = n0 & 127;
            const float* g = (second ? p.in[26] : p.in[3]) + (size_t)l * DM * DFF; const float* up = (second ? p.in[27] : p.in[4]) + (size_t)l * DM * DFF;
            src = (bj ? up : g) + (size_t)(tk * 64) * DFF + pn * 128 + i0; ld_src = DFF;
            dst = Wl + (second ? WO_GU2 : WO_GU1) + (size_t)n0 * DM + tk * 64; ld_dst = DM;
        } else if (r < 2112 || r >= 4416) {
            const bool second = r >= 4416; r -= second ? 4416 : 1408;
            const int tn = r / 44, tk = r % 44;
            src = (second ? p.in[28] : p.in[5]) + (size_t)l * DFF * DM + (size_t)(tk * 64) * DM + tn * 64; ld_src = DM;
            dst = Wl + (second ? WO_D2 : WO_D1) + (size_t)(tn * 64) * DFF + tk * 64; ld_dst = DFF;
        } else if (r < 2688) {
            r -= 2112; const int tn = r >> 4, tk = r & 15, n0 = tn * 64, c0 = n0 < 1792 ? n0 : n0 + 8;
            src = p.in[7] + (size_t)l * DM * INW + (size_t)(tk * 64) * INW + c0; ld_src = INW;
            dst = Wl + WO_IN + (size_t)n0 * DM + tk * 64; ld_dst = DM;
        } else if (r < 2752) {
            r -= 2688; const int tn = r >> 3, tk = r & 7;
            src = p.in[21] + (size_t)l * 512 * 512 + (size_t)(tk * 64) * 512 + tn * 64; ld_src = 512;
            dst = Wl + WO_GLU + (size_t)(tn * 64) * 512 + tk * 64; ld_dst = 512;
        } else {
            r -= 2752; const int tn = r >> 4, tk = r & 15;
            src = p.in[24] + (size_t)l * DM * DM + (size_t)(tk * 64) * DM + tn * 64; ld_src = DM;
            dst = Wl + WO_OUT + (size_t)(tn * 64) * DM + tk * 64; ld_dst = DM;
        }
        return CvtTile{src, dst, ld_src, ld_dst};
}
__device__ __forceinline__ void convert_weights(const Params& p, LAS unsigned char* lds) {
    LAS float* T = (LAS float*)lds;
    const int tid = otid(), kr = tid >> 4, c4 = (tid & 15) * 4, n = tid >> 3, k8 = (tid & 7) * 8;
    int t = obid();
    if (t >= 2 * 5120) return;
    CvtTile cur = convert_desc(p, t);
    f32x4 v0 = *(const f32x4*)(cur.src + (size_t)kr * cur.ld_src + c4), v1 = *(const f32x4*)(cur.src + (size_t)(kr + 32) * cur.ld_src + c4);
    for (;;) {
        const int tn = t + (int)gridDim.x; const bool has = tn < 2 * 5120;
        CvtTile nxt = cur; f32x4 w0 = v0, w1 = v1;
        if (has) { nxt = convert_desc(p, tn); w0 = *(const f32x4*)(nxt.src + (size_t)kr * nxt.ld_src + c4); w1 = *(const f32x4*)(nxt.src + (size_t)(kr + 32) * nxt.ld_src + c4); }
        T[kr * 65 + c4 + 0] = v0[0]; T[kr * 65 + c4 + 1] = v0[1]; T[kr * 65 + c4 + 2] = v0[2]; T[kr * 65 + c4 + 3] = v0[3];
        T[(kr + 32) * 65 + c4 + 0] = v1[0]; T[(kr + 32) * 65 + c4 + 1] = v1[1]; T[(kr + 32) * 65 + c4 + 2] = v1[2]; T[(kr + 32) * 65 + c4 + 3] = v1[3];
        __syncthreads();
        { u32x4 w;
          w.x = pack2(T[(k8 + 0) * 65 + n], T[(k8 + 1) * 65 + n]); w.y = pack2(T[(k8 + 2) * 65 + n], T[(k8 + 3) * 65 + n]);
          w.z = pack2(T[(k8 + 4) * 65 + n], T[(k8 + 5) * 65 + n]); w.w = pack2(T[(k8 + 6) * 65 + n], T[(k8 + 7) * 65 + n]);
          *(u32x4*)(cur.dst + (size_t)n * cur.ld_dst + k8) = w; }
        __syncthreads();
        if (!has) break;
        cur = nxt; v0 = w0; v1 = w1; t = tn;
    }
}
__device__ __forceinline__ void s5_params(const Params& p) {
    const int gt = obid() * NTHR + otid();
    if (gt >= 2 * 32 * 64) return;
    const int l = gt >> 11, g = (gt >> 6) & 31, q = gt & 63;
    float* P = (float*)(p.ws + WS_S5P) + (size_t)l * S5P_L;
    const float are = p.in[13][gt], aim = p.in[14][gt], dt = expf(p.in[15][l * 32 + g]);
    const float mag = expf(are * dt), ar = mag * cosf(aim * dt), ai = mag * sinf(aim * dt);
    P[(g * 64 + q) * 2] = ar; P[(g * 64 + q) * 2 + 1] = ai;
    float pr = ar, pi = ai;
#pragma unroll
    for (int i = 0; i < 6; ++i) { const float nr = pr * pr - pi * pi, ni = 2.f * pr * pi; pr = nr; pi = ni; }
    P[4096 + (g * 64 + q) * 2] = pr; P[4096 + (g * 64 + q) * 2 + 1] = pi;
    const float nre = ar - 1.f, nim = ai, den = 1.f / (are * are + aim * aim);
    const float cr = (nre * are + nim * aim) * den, ci = (nim * are - nre * aim) * den;
    const float* bre = p.in[16] + (size_t)gt * 16; const float* bim = p.in[17] + (size_t)gt * 16;
#pragma unroll
    for (int c = 0; c < 16; ++c) { const float br = bre[c], bi = bim[c];
        P[8192 + ((g * 16 + c) * 64 + q) * 2] = cr * br - ci * bi; P[8192 + ((g * 16 + c) * 64 + q) * 2 + 1] = cr * bi + ci * br; }
}

template <int MODE> __device__ __forceinline__ void norm_rows(const Params& p, LAS unsigned char* lds, const float* gain, int layer) {
    const int tid = otid(), lane = tid & 63, wid = tid >> 6;
    float* H = (float*)(p.ws + WS_H); bf16_t* XN = (bf16_t*)(p.ws + WS_XN);
    LAS float* wba = (LAS float*)lds;
    if (MODE == 1) {
        const float* win = p.in[7] + (size_t)layer * DM * INW;
        for (int i = tid; i < 2048; i += NTHR) { const int k = i >> 1, h = i & 1; const f32x4 v = *(const f32x4*)(win + (size_t)k * INW + 1792 + 4 * h);
            wba[k * 8 + 4 * h + 0] = v[0]; wba[k * 8 + 4 * h + 1] = v[1]; wba[k * 8 + 4 * h + 2] = v[2]; wba[k * 8 + 4 * h + 3] = v[3]; }
        __syncthreads();
    }
    for (int row0 = obid() * 8 + wid; row0 < MROWS; row0 += gridDim.x * 16) {
        f32x4 vv[2][4];
#pragma unroll
        for (int k2 = 0; k2 < 2; ++k2) {
            const int row = row0 + k2 * (int)gridDim.x * 8;
            if (row < MROWS) {
                const int b = row / LP, posb = row - b * LP; (void)b; (void)posb;
                f32x4 (&v)[4] = vv[k2];
                if (MODE == 3) {
                    const float* src = nullptr;
                    if (posb >= 128) src = p.in[0] + ((size_t)b * SEQ + (posb - 128)) * DM; else if (posb >= PADF) src = p.in[1] + (size_t)(posb - PADF) * DM;
#pragma unroll
                    for (int i = 0; i < 4; ++i) { v[i] = src ? *(const f32x4*)(src + (lane + 64 * i) * 4) : (f32x4){0.f, 0.f, 0.f, 0.f}; *(f32x4*)(H + (size_t)row * DM + (lane + 64 * i) * 4) = v[i]; }
                } else {
#pragma unroll
                    for (int i = 0; i < 4; ++i) v[i] = *(const f32x4*)(H + (size_t)row * DM + (lane + 64 * i) * 4);
                }
            }
        }
#pragma unroll
        for (int k2 = 0; k2 < 2; ++k2) {
            const int row = row0 + k2 * (int)gridDim.x * 8;
            if (row < MROWS) {
                const int b = row / LP, posb = row - b * LP; (void)b; (void)posb;
                f32x4 (&v)[4] = vv[k2];
                float ss = 0.f;
#pragma unroll
                for (int i = 0; i < 4; ++i) ss += v[i][0] * v[i][0] + v[i][1] * v[i][1] + v[i][2] * v[i][2] + v[i][3] * v[i][3];
#pragma unroll
                for (int d = 1; d < 64; d <<= 1) ss += __shfl_xor(ss, d);
                const float rstd = rsqrtf(ss * (1.f / 1024.f) + 1e-6f);
                float ba[8];
#pragma unroll
                for (int e = 0; e < 8; ++e) ba[e] = 0.f;
#pragma unroll
                for (int i = 0; i < 4; ++i) {
                    const f32x4 g4 = *(const f32x4*)(gain + (lane + 64 * i) * 4);
                    const f32x4 y = v[i] * g4 * rstd;
                    if (MODE == 2) { if (posb >= 128) *(f32x4*)(p.out + ((size_t)b * SEQ + (posb - 128)) * DM + (lane + 64 * i) * 4) = y; }
                    else { u32x2 w; w.x = pack2(y[0], y[1]); w.y = pack2(y[2], y[3]); *(u32x2*)(XN + (size_t)row * DM + (lane + 64 * i) * 4) = w; }
                    if (MODE == 1) {
#pragma unroll
                        for (int j = 0; j < 4; ++j) { const int k = (lane + 64 * i) * 4 + j;
#pragma unroll
                            for (int e = 0; e < 8; ++e) ba[e] += y[j] * wba[k * 8 + e]; }
                    }
                }
                if (MODE == 1) {
#pragma unroll
                    for (int e = 0; e < 8; ++e) {
#pragma unroll
                        for (int d = 1; d < 64; d <<= 1) ba[e] += __shfl_xor(ba[e], d); }
                    if (lane == 0) { float* o = (float*)(p.ws + WS_BA) + (size_t)row * 8;
#pragma unroll
                        for (int e = 0; e < 8; ++e) o[e] = ba[e]; }
                }

            }
        }
    }
    if (MODE == 1) __syncthreads();
}

#define XB_TMO      128
#define XB_XCNT(j)  (256  + 64 * (j))
#define XB_XSUB(j)  (1280 + 64 * (j))
#define XB_XGEN(j)  (2304 + 64 * (j))
#define XB_TOP      3328
#define XB_TOPGEN   3392
#define XCD_BAR_WORDS 3456
#define XB_SPIN_CAP (1u << 18)

__device__ __forceinline__ unsigned xb_ld(unsigned* p)              { return __hip_atomic_load(p, __ATOMIC_RELAXED, __HIP_MEMORY_SCOPE_AGENT); }
__device__ __forceinline__ unsigned xb_add(unsigned* p, unsigned v) { return __hip_atomic_fetch_add(p, v, __ATOMIC_RELAXED, __HIP_MEMORY_SCOPE_AGENT); }
__device__ __forceinline__ unsigned xb_xcc_id() { return (unsigned)__builtin_amdgcn_s_getreg((3 << 11) | 20) & 0xFu; }
#define XB_SPIN(cond, bar) do { unsigned _sp = 0; while (cond) { __builtin_amdgcn_s_sleep(1); \
    if ((++_sp & 255u) == 0u) { if (xb_ld(&(bar)[XB_TMO])) break; if (_sp > XB_SPIN_CAP) { atomicAdd(&(bar)[XB_TMO], 1u); break; } } } } while (0)

struct XcdBarrier {
    unsigned* bar; unsigned x;
    volatile LAS unsigned* st;
};

__device__ __forceinline__ XcdBarrier xcd_barrier_post(unsigned* bar, volatile LAS unsigned* st) {
    XcdBarrier b; b.bar = bar; b.x = xb_xcc_id(); b.st = st;
    if (otid() == 0) (void)xb_add(&bar[XB_XCNT(b.x)], 1u);
    return b;
}
__device__ __forceinline__ void xcd_barrier_complete(unsigned* bar, unsigned x, unsigned& nloc, unsigned& nx) {
    const unsigned G = gridDim.x * gridDim.y * gridDim.z;
    unsigned sum, cnt, mine, sp = 0u;
    for (;;) {
        sum = 0u; cnt = 0u; mine = 0u;
#pragma unroll
        for (unsigned j = 0; j < 16; ++j) { const unsigned c = xb_ld(&bar[XB_XCNT(j)]); sum += c; cnt += (c > 0u) ? 1u : 0u; mine = (j == x) ? c : mine; }
        if (sum == G) break;
        __builtin_amdgcn_s_sleep(1);
        if ((++sp & 255u) == 0u) { if (xb_ld(&bar[XB_TMO])) break; if (sp > XB_SPIN_CAP) { atomicAdd(&bar[XB_TMO], 1u); break; } }
    }
    nloc = mine > 0u ? mine : 1u; nx = cnt > 0u ? cnt : 1u;
}

__device__ __forceinline__ void xcd_barrier(const XcdBarrier& b) {
    asm volatile("s_waitcnt vmcnt(0)" ::: "memory");
    __syncthreads();
    if (otid() == 0) {
        unsigned* bar = b.bar;
        __builtin_amdgcn_s_waitcnt(0);
        unsigned nloc = b.st[0], nx = b.st[1];
        if (nloc == 0u) { xcd_barrier_complete(bar, b.x, nloc, nx); b.st[0] = nloc; b.st[1] = nx; }
        const unsigned old = xb_add(&bar[XB_XSUB(b.x)], 1u);
        const unsigned gen = old / nloc;
        if (old + 1u == (gen + 1u) * nloc) {
            __builtin_amdgcn_fence(__ATOMIC_RELEASE, "agent");
            asm volatile("s_waitcnt vmcnt(0)" ::: "memory");
            const unsigned og = xb_add(&bar[XB_TOP], 1u);
            const unsigned tg = og / nx;
            if (og + 1u == (tg + 1u) * nx) xb_add(&bar[XB_TOPGEN], 1u);
            else XB_SPIN(xb_ld(&bar[XB_TOPGEN]) == tg, bar);
            __builtin_amdgcn_fence(__ATOMIC_ACQUIRE, "agent");
            xb_add(&bar[XB_XGEN(b.x)], 1u);
            asm volatile("s_waitcnt vmcnt(0)" ::: "memory");
        } else {
            XB_SPIN(xb_ld(&bar[XB_XGEN(b.x)]) == gen, bar);
            __builtin_amdgcn_fence(__ATOMIC_ACQUIRE, "agent");
            asm volatile("s_waitcnt vmcnt(0)" ::: "memory");
        }
    }
    __syncthreads();
}


template <int N> __device__ __forceinline__ float row_shl(float v) { return __int_as_float(__builtin_amdgcn_update_dpp(0, __float_as_int(v), 0x100 + N, 0xf, 0xf, true)); }
__device__ __forceinline__ void sb_item(LAS unsigned char* lds, int item, const bf16_t* proj, bf16_t* mixed, const float* gain) {
    const int tid = otid(), lane = tid & 63, wid = tid >> 6, fr = lane & 15, fq = lane >> 4;
    const int qb = item % NQB, bh = item / NQB, b = bh >> 2, hd = bh & 3;
    LAS bf16_t* Qs = (LAS bf16_t*)lds;
    LAS bf16_t* Ks = Qs + 128 * 72;
    LAS bf16_t* Vt = Ks + 128 * 72;
    LAS bf16_t* Ps = Vt + 64 * 136 + wid * (16 * 136);
    const size_t rowbase = (size_t)b * LP;
    { const int r = tid >> 2, seg = tid & 3;
      const bf16_t* src = proj + (rowbase + (size_t)qb * 128 + r) * PW + hd * 64 + seg * 16;
      const u32x4 v0 = *(const u32x4*)src, v1 = *(const u32x4*)(src + 8);
      *(LAS u32x4*)(Qs + r * 72 + seg * 16) = v0; *(LAS u32x4*)(Qs + r * 72 + seg * 16 + 8) = v1; }
    f32x4 o[4];
#pragma unroll
    for (int i = 0; i < 4; ++i) o[i] = (f32x4){0.f, 0.f, 0.f, 0.f};
    float carry[4] = {0.f, 0.f, 0.f, 0.f};
    bf16x8 qa[2];
    u32x4 k0, k1, v0, v1;
    { const int r = tid >> 2, seg = tid & 3;
      const bf16_t* srck = proj + (rowbase + (size_t)qb * 128 + r) * PW + 256 + hd * 64 + seg * 16;
      k0 = *(const u32x4*)srck; k1 = *(const u32x4*)(srck + 8); v0 = *(const u32x4*)(srck + 256); v1 = *(const u32x4*)(srck + 264); }
    for (int kb = qb; kb >= 0; --kb) {
        { const int r = tid >> 2, seg = tid & 3;
          *(LAS u32x4*)(Ks + r * 72 + seg * 16) = k0; *(LAS u32x4*)(Ks + r * 72 + seg * 16 + 8) = k1;
          LAS bf16_t* vt = Vt + (seg * 16) * 136 + r;
          vt[0 * 136] = (bf16_t)(v0.x & 0xffff); vt[1 * 136] = (bf16_t)(v0.x >> 16); vt[2 * 136] = (bf16_t)(v0.y & 0xffff); vt[3 * 136] = (bf16_t)(v0.y >> 16);
          vt[4 * 136] = (bf16_t)(v0.z & 0xffff); vt[5 * 136] = (bf16_t)(v0.z >> 16); vt[6 * 136] = (bf16_t)(v0.w & 0xffff); vt[7 * 136] = (bf16_t)(v0.w >> 16);
          vt[8 * 136] = (bf16_t)(v1.x & 0xffff); vt[9 * 136] = (bf16_t)(v1.x >> 16); vt[10 * 136] = (bf16_t)(v1.y & 0xffff); vt[11 * 136] = (bf16_t)(v1.y >> 16);
          vt[12 * 136] = (bf16_t)(v1.z & 0xffff); vt[13 * 136] = (bf16_t)(v1.z >> 16); vt[14 * 136] = (bf16_t)(v1.w & 0xffff); vt[15 * 136] = (bf16_t)(v1.w >> 16); }
        __syncthreads();
        if (kb > 0) { const int r = tid >> 2, seg = tid & 3;
            const bf16_t* srck = proj + (rowbase + (size_t)(kb - 1) * 128 + r) * PW + 256 + hd * 64 + seg * 16;
            k0 = *(const u32x4*)srck; k1 = *(const u32x4*)(srck + 8); v0 = *(const u32x4*)(srck + 256); v1 = *(const u32x4*)(srck + 264); }
        if (kb == qb) {
#pragma unroll
            for (int ks = 0; ks < 2; ++ks) qa[ks] = *(const LAS bf16x8*)(Qs + (wid * 16 + fr) * 72 + ks * 32 + fq * 8);
        }
        f32x4 z[8];
#pragma unroll
        for (int f = 0; f < 8; ++f) { z[f] = (f32x4){0.f, 0.f, 0.f, 0.f};
#pragma unroll
            for (int ks = 0; ks < 2; ++ks) { const bf16x8 kf = *(const LAS bf16x8*)(Ks + (f * 16 + fr) * 72 + ks * 32 + fq * 8); z[f] = mfma16(qa[ks], kf, z[f]); } }
        const int qpos0 = qb * 128 + wid * 16 + fq * 4;
        float lk[8][4];
#pragma unroll
        for (int f = 0; f < 8; ++f) { const int kpos = kb * 128 + f * 16 + fr;
#pragma unroll
            for (int r = 0; r < 4; ++r) { const bool valid = (kpos < qpos0 + r) & (kpos >= PADF);
                const float zs = z[f][r] * 0.125f; z[f][r] = zs; const float sp = softplus_fast(zs); float v = valid ? -sp : 0.f;
                v += row_shl<1>(v); v += row_shl<2>(v); v += row_shl<4>(v); v += row_shl<8>(v);
                lk[f][r] = v; } }
#pragma unroll
        for (int r = 0; r < 4; ++r) { float run = carry[r];
#pragma unroll
            for (int f = 7; f >= 0; --f) { const int kpos = kb * 128 + f * 16 + fr; const bool valid = (kpos < qpos0 + r) & (kpos >= PADF);
                const float tot = __shfl(lk[f][r], 0, 16);
                const float ew = __expf(fminf(z[f][r] + lk[f][r] + run, 0.f));
                const float w = valid ? ew : 0.f;
                run += tot;
                Ps[(fq * 4 + r) * 136 + f * 16 + fr] = f2bf(w); }
            carry[r] = run; }
        WAVE_LDS_SYNC();
#pragma unroll
        for (int ks = 0; ks < 4; ++ks) { const bf16x8 pa = *(const LAS bf16x8*)(Ps + fr * 136 + ks * 32 + fq * 8);
#pragma unroll
            for (int df = 0; df < 4; ++df) { const bf16x8 vb = *(const LAS bf16x8*)(Vt + (df * 16 + fr) * 136 + ks * 32 + fq * 8); o[df] = mfma16(pa, vb, o[df]); } }
        const bool wdone = (carry[0] < -60.f) && (carry[1] < -60.f) && (carry[2] < -60.f) && (carry[3] < -60.f);
        const int cont = __syncthreads_or(wdone ? 0 : 1);
        if (!cont) break;
    }
#pragma unroll
    for (int r = 0; r < 4; ++r) { float ss = 0.f;
#pragma unroll
        for (int df = 0; df < 4; ++df) ss += o[df][r] * o[df][r];
#pragma unroll
        for (int d = 1; d < 16; d <<= 1) ss += __shfl_xor(ss, d, 16);
        const float rstd = rsqrtf(ss * (1.f / 64.f) + 1e-6f);
        bf16_t* dst = mixed + (rowbase + (size_t)qb * 128 + wid * 16 + fq * 4 + r) * DM + hd * 64;
#pragma unroll
        for (int df = 0; df < 4; ++df) dst[df * 16 + fr] = f2bf(o[df][r] * rstd * gain[df * 16 + fr]); }
}

struct DNBufs { bf16_t* W; bf16_t* QG; bf16_t* ATT; bf16_t* KT; bf16_t* UT; float* EGL; float* ODN; };
__device__ __forceinline__ DNBufs dn_bufs(const Params& p) {
    unsigned char* o = (unsigned char*)p.out;
    return DNBufs{(bf16_t*)(o + DO_W), (bf16_t*)(o + DO_QG), (bf16_t*)(o + DO_ATT), (bf16_t*)(o + DO_KT), (bf16_t*)(o + DO_UT), (float*)(o + DO_EGL), (float*)(o + DO_ODN)};
}
__device__ __forceinline__ void dn_local_item(const Params& p, LAS unsigned char* lds, int item, int layer, const bf16_t* proj, const DNBufs& D) {
    const int tid = otid(), lane = tid & 63, wid = tid >> 6, fr = lane & 15, fq = lane >> 4;
    const int n = item % NCH, bh = item / NCH, b = bh >> 2, hd = bh & 3;
    LAS float* Qf = (LAS float*)lds;
    LAS float* Kf = Qf + 64 * 65;
    LAS float* Vf = Kf + 64 * 65;
    LAS float* Lm = Vf + 64 * 65;
    LAS float* gcs = Lm + 64 * 68;
    LAS float* bts = gcs + 64;
    LAS float* scw = bts + 64;
    LAS bf16_t* Qb = (LAS bf16_t*)(scw + 64);
    LAS bf16_t* Kb = Qb + 64 * 72;
    LAS bf16_t* KTs = Kb + 64 * 72;
    LAS bf16_t* ATs = KTs + 64 * 72;
    LAS bf16_t* WTs = ATs + 64 * 72;
    LAS bf16_t* UTs = WTs + 64 * 72;
    const float* cw = p.in[9] + (size_t)layer * 4 * 768;
    const size_t pos0 = (size_t)b * LP + (size_t)n * 64;
    if (tid < 384) {
        const int cc = tid % 192, rg = tid / 192, which = cc >> 6, d = cc & 63, ch = which * 256 + hd * 64 + d;
        LAS float* dst = (which == 0 ? Qf : (which == 1 ? Kf : Vf)) + d;
        const float w0 = cw[ch], w1 = cw[768 + ch], w2 = cw[2 * 768 + ch], w3 = cw[3 * 768 + ch];
        const int r0 = rg * 32;
        if (n * 64 + r0 + 31 < PADF) {
#pragma unroll
            for (int i = 0; i < 32; ++i) dst[(r0 + i) * 65] = 0.f;
        } else {
            const bf16_t* src = proj + (pos0 + r0) * PW + 768 + ch;
            bf16_t xv[35];
#pragma unroll
            for (int i = 0; i < 35; ++i) xv[i] = src[((long)i - 3) * PW];
#pragma unroll
            for (int i = 0; i < 32; ++i) {
                const float a = w0 * bf2f(xv[i]) + w1 * bf2f(xv[i + 1]) + w2 * bf2f(xv[i + 2]) + w3 * bf2f(xv[i + 3]);
                dst[(r0 + i) * 65] = silu_fast(a) * ((n * 64 + r0 + i >= PADF) ? 1.f : 0.f);
            }
        }
    }
    if (tid < 64) {
        const int posb = n * 64 + tid; float g = 0.f, bt = 0.f;
        if (posb >= PADF) { const float* bar = (const float*)(p.ws + WS_BA) + (pos0 + tid) * 8;
            bt = 1.f / (1.f + __expf(-bar[hd]));
            const float x = bar[4 + hd] + p.in[11][layer * 4 + hd];
            g = -__expf(p.in[10][layer * 4 + hd]) * softplus_fast(x); }
        float c = g;
#pragma unroll
        for (int d = 1; d < 64; d <<= 1) { const float t = __shfl_up(c, d); if (lane >= d) c += t; }
        gcs[tid] = c; bts[tid] = bt; scw[tid] = bt * __expf(c);
    }
    __syncthreads();
    {
        const int row = tid >> 2, part = tid & 3, r = row & 63;
        LAS float* X = ((row >> 6) ? Kf : Qf) + r * 65 + part * 16; LAS bf16_t* Xb = ((row >> 6) ? Kb : Qb) + r * 72 + part * 16;
        float xv[16]; float ss = 0.f;
#pragma unroll
        for (int j = 0; j < 16; ++j) { xv[j] = X[j]; ss += xv[j] * xv[j]; }
        ss += __shfl_xor(ss, 1); ss += __shfl_xor(ss, 2);
        const float rs = rsqrtf(ss + 1e-6f);
#pragma unroll
        for (int j = 0; j < 16; j += 2) { const float a0 = xv[j] * rs, a1 = xv[j + 1] * rs; X[j] = a0; X[j + 1] = a1; *(LAS unsigned*)(Xb + j) = pack2(a0, a1); }
    }
    __syncthreads();
    const size_t ob = (size_t)item * 4096;
    const float glast = gcs[63];
#pragma unroll
    for (int idx = tid; idx < 4096; idx += NTHR) {
        const int hi = idx >> 6, lo = idx & 63;
        KTs[hi * 72 + lo] = f2bf(Kf[lo * 65 + hi] * __expf(glast - gcs[lo]));
    }
    if (tid == 0) D.EGL[item] = __expf(glast);
#pragma unroll
    for (int q4 = 0; q4 < 4; ++q4) {
        const int fid = wid * 4 + q4, gram = fid >> 4, fi = (fid >> 2) & 3, fj = fid & 3;
        LAS bf16_t* X = gram ? Qb : Kb;
        f32x4 acc = (f32x4){0.f, 0.f, 0.f, 0.f};
#pragma unroll
        for (int ks = 0; ks < 2; ++ks) { const bf16x8 a = *(const LAS bf16x8*)(X + (fi * 16 + fr) * 72 + ks * 32 + fq * 8);
            const bf16x8 bb = *(const LAS bf16x8*)(Kb + (fj * 16 + fr) * 72 + ks * 32 + fq * 8); acc = mfma16(a, bb, acc); }
        const int j = fj * 16 + fr; const float gj = gcs[j];
#pragma unroll
        for (int r = 0; r < 4; ++r) { const int i = fi * 16 + fq * 4 + r;
            const float de_ = __expf(fminf(gcs[i] - gj, 0.f)); const float dec = (i >= j) ? de_ : 0.f;
            if (gram == 0) Lm[i * 68 + j] = (i > j) ? bts[i] * acc[r] * dec : 0.f;
            else ATs[i * 72 + j] = f2bf(acc[r] * 0.125f * dec); }
    }
    __syncthreads();
    if (tid < 128) {
        const int col = tid & 63; const bool isw = tid >= 64;
        LAS float* X = (isw ? Kf : Vf) + col;
        const LAS float* sc = isw ? scw : bts;
        float x[64];
#pragma unroll
        for (int I = 0; I < 4; ++I) {
            float r[16];
#pragma unroll
            for (int ii = 0; ii < 16; ++ii) { const int i = I * 16 + ii; r[ii] = X[i * 65] * sc[i]; }
            asm volatile("" ::: "memory");
#pragma unroll
            for (int J = 0; J < I; ++J) {
#pragma unroll
                for (int ii = 0; ii < 16; ++ii) { const int i = I * 16 + ii;
#pragma unroll
                    for (int j4 = 0; j4 < 4; ++j4) { const f32x4 l4 = *(const LAS f32x4*)(Lm + i * 68 + J * 16 + j4 * 4);
                        r[ii] -= l4[0] * x[J * 16 + j4 * 4] + l4[1] * x[J * 16 + j4 * 4 + 1] + l4[2] * x[J * 16 + j4 * 4 + 2] + l4[3] * x[J * 16 + j4 * 4 + 3]; }
                    if ((ii & 3) == 3) asm volatile("" ::: "memory");
                }
            }
#pragma unroll
            for (int ii = 0; ii < 16; ++ii) { const int i = I * 16 + ii; float sacc = r[ii];
#pragma unroll
                for (int jj = 0; jj < ii; ++jj) sacc -= Lm[i * 68 + I * 16 + jj] * x[I * 16 + jj];
                x[i] = sacc; X[i * 65] = sacc;
                if ((ii & 3) == 3) asm volatile("" ::: "memory");
            }
        }
    }
    __syncthreads();
#pragma unroll
    for (int idx = tid; idx < 4096; idx += NTHR) {
        const int hi = idx >> 6, lo = idx & 63;
        WTs[hi * 72 + lo] = f2bf(Kf[lo * 65 + hi]);
        UTs[hi * 72 + lo] = f2bf(Vf[lo * 65 + hi]);
    }
    __syncthreads();
    {   const int mt = wid >> 1, half = wid & 1;
        const LAS bf16_t* Xs = (mt == 0 || mt == 2) ? KTs : ATs;
        const LAS bf16_t* Ys = mt < 2 ? WTs : UTs;
        bf16_t* dstp = mt == 0 ? D.W : (mt == 1 ? D.QG : (mt == 2 ? D.ATT : D.KT));
#pragma unroll
        for (int q8 = 0; q8 < 8; ++q8) {
            const int fi = half * 2 + (q8 >> 2), fj = q8 & 3;
            f32x4 acc = (f32x4){0.f, 0.f, 0.f, 0.f};
#pragma unroll
            for (int ks = 0; ks < 2; ++ks) acc = mfma16(*(const LAS bf16x8*)(Xs + (fi * 16 + fr) * 72 + ks * 32 + fq * 8), *(const LAS bf16x8*)(Ys + (fj * 16 + fr) * 72 + ks * 32 + fq * 8), acc);
            if (mt == 0) {
#pragma unroll
                for (int r = 0; r < 4; ++r) dstp[ob + (fi * 16 + fq * 4 + r) * 64 + fj * 16 + fr] = f2bf(-acc[r]);
            } else if (mt == 1) {
#pragma unroll
                for (int r = 0; r < 4; ++r) { const int c = fi * 16 + fq * 4 + r; dstp[ob + c * 64 + fj * 16 + fr] = f2bf(Qf[c * 65 + fj * 16 + fr] * 0.125f * __expf(gcs[c]) - acc[r]); }
            } else {
                u32x2 w; w.x = pack2(acc[0], acc[1]); w.y = pack2(acc[2], acc[3]);
                *(u32x2*)(dstp + ob + (fj * 64 + lane) * 16 + fi * 4) = w;
            }
        }
    }
    __syncthreads();
}

__device__ __forceinline__ void dn_seq_compute(const LAS bf16_t* MYs, f32x4 (&ST)[4], float egl_cur, float* odst, int dvb, int lane, int fr, int fq) {
    constexpr int MATE = 64 * 72;
    const LAS bf16_t* CYs = MYs + MATE; const LAS bf16_t* BNs = MYs + 2 * MATE; const LAS bf16_t* DNs = BNs + 4096;
    bf16x8 amy[4][2], acy[4][2];
#pragma unroll
    for (int f = 0; f < 4; ++f)
#pragma unroll
        for (int ks = 0; ks < 2; ++ks) { const int o_ = (f * 16 + fr) * 72 + ks * 32 + fq * 4;
            const u32x2 m0 = *(const LAS u32x2*)(MYs + o_), m1 = *(const LAS u32x2*)(MYs + o_ + 16), c0 = *(const LAS u32x2*)(CYs + o_), c1 = *(const LAS u32x2*)(CYs + o_ + 16);
            const u32x4 mm = {m0.x, m0.y, m1.x, m1.y}, cc = {c0.x, c0.y, c1.x, c1.y};
            amy[f][ks] = __builtin_bit_cast(bf16x8, mm); acy[f][ks] = __builtin_bit_cast(bf16x8, cc); }
    const u32x4 b0 = *(const LAS u32x4*)(BNs + (dvb * 64 + lane) * 16), b1 = *(const LAS u32x4*)(BNs + (dvb * 64 + lane) * 16 + 8);
    const u32x4 d0 = *(const LAS u32x4*)(DNs + (dvb * 64 + lane) * 16), d1 = *(const LAS u32x4*)(DNs + (dvb * 64 + lane) * 16 + 8);
    bf16x8 bop[2];
#pragma unroll
    for (int ks = 0; ks < 2; ++ks) { const u32x4 w = {pack2(ST[2 * ks][0], ST[2 * ks][1]), pack2(ST[2 * ks][2], ST[2 * ks][3]), pack2(ST[2 * ks + 1][0], ST[2 * ks + 1][1]), pack2(ST[2 * ks + 1][2], ST[2 * ks + 1][3])};
        bop[ks] = __builtin_bit_cast(bf16x8, w); }
    f32x4 o[4];
    o[0] = (f32x4){bflo(d0.x), bfhi(d0.x), bflo(d0.y), bfhi(d0.y)}; o[1] = (f32x4){bflo(d0.z), bfhi(d0.z), bflo(d0.w), bfhi(d0.w)};
    o[2] = (f32x4){bflo(d1.x), bfhi(d1.x), bflo(d1.y), bfhi(d1.y)}; o[3] = (f32x4){bflo(d1.z), bfhi(d1.z), bflo(d1.w), bfhi(d1.w)};
    ST[0] = ST[0] * egl_cur + (f32x4){bflo(b0.x), bfhi(b0.x), bflo(b0.y), bfhi(b0.y)}; ST[1] = ST[1] * egl_cur + (f32x4){bflo(b0.z), bfhi(b0.z), bflo(b0.w), bfhi(b0.w)};
    ST[2] = ST[2] * egl_cur + (f32x4){bflo(b1.x), bfhi(b1.x), bflo(b1.y), bfhi(b1.y)}; ST[3] = ST[3] * egl_cur + (f32x4){bflo(b1.z), bfhi(b1.z), bflo(b1.w), bfhi(b1.w)};
#pragma unroll
    for (int f = 0; f < 4; ++f)
#pragma unroll
        for (int ks = 0; ks < 2; ++ks) { o[f] = mfma16(acy[f][ks], bop[ks], o[f]); ST[f] = mfma16(amy[f][ks], bop[ks], ST[f]); }
#pragma unroll
    for (int cf = 0; cf < 4; ++cf)
#pragma unroll
        for (int r = 0; r < 4; ++r) odst[(size_t)(cf * 16 + fq * 4 + r) * 256 + fr] = o[cf][r];
}
struct DNStage { u32x4 r0, r1, r2, r3; };
__device__ __forceinline__ void dn_seq_block(LAS unsigned char* lds, int bh, const DNBufs& D) {
    const int tid = otid(), lane = tid & 63, wid = tid >> 6, fr = lane & 15, fq = lane >> 4;
    const int b = bh >> 2, hd = bh & 3, dvb = wid;
    constexpr int MATE = 64 * 72;
    constexpr int BUFE = 2 * MATE + 2 * 4096;
    LAS bf16_t* L0 = (LAS bf16_t*)lds;
    LAS bf16_t* STb = L0 + 2 * BUFE + wid * (16 * 72);
    LAS float* egls = (LAS float*)(L0 + 2 * BUFE + 8 * (16 * 72));
    const int goff = tid * 8, loff = (tid >> 3) * 72 + (tid & 7) * 8;
#define DN_GLOAD(S, nq) do { const int nq_ = (nq) < NCH ? (nq) : NCH - 1; const size_t ob_ = (size_t)(bh * NCH + nq_) * 4096 + goff; S.r0 = *(const u32x4*)(D.W + ob_); S.r1 = *(const u32x4*)(D.QG + ob_); \
        S.r2 = *(const u32x4*)(D.ATT + ob_); S.r3 = *(const u32x4*)(D.KT + ob_); } while (0)
#define DN_LSTORE(S, bq) do { LAS bf16_t* B_ = L0 + (bq) * BUFE; *(LAS u32x4*)(B_ + loff) = S.r0; *(LAS u32x4*)(B_ + MATE + loff) = S.r1; *(LAS u32x4*)(B_ + 2 * MATE + goff) = S.r2; \
        *(LAS u32x4*)(B_ + 2 * MATE + 4096 + goff) = S.r3; } while (0)
    DNStage s0, s1, s2;
    if (tid < NCH) egls[tid] = D.EGL[bh * NCH + tid];
    DN_GLOAD(s0, 0); DN_LSTORE(s0, 0);
    DN_GLOAD(s0, 1); DN_GLOAD(s1, 2); DN_GLOAD(s2, 3);
    __syncthreads();
    f32x4 ST[4];
#pragma unroll
    for (int f = 0; f < 4; ++f) ST[f] = (f32x4){0.f, 0.f, 0.f, 0.f};
#define DN_STEP(n, S) do { \
        DN_LSTORE(S, ((n) + 1) & 1); DN_GLOAD(S, (n) + 4); \
        if (wid < 4) dn_seq_compute(L0 + ((n) & 1) * BUFE, ST, egls[n], D.ODN + ((size_t)b * LP + (size_t)(n) * 64) * 256 + hd * 64 + dvb * 16, dvb, lane, fr, fq); \
        asm volatile("s_waitcnt lgkmcnt(0)" ::: "memory"); __builtin_amdgcn_s_barrier(); asm volatile("" ::: "memory"); } while (0)
    for (int n = 0; n < NCH; n += 3) { DN_STEP(n, s0); DN_STEP(n + 1, s1); DN_STEP(n + 2, s2); }
#undef DN_STEP
#undef DN_GLOAD
#undef DN_LSTORE
}

struct S5Coef { float ar, ai; float bre[16], bim[16]; bf16x8 cmb[4]; float dd; };
template <bool FINAL> __device__ __forceinline__ void s5_load_coef(const Params& p, int layer, int g, S5Coef& K) {
    const int lane = otid() & 63, fr = lane & 15, fq = lane >> 4;
    const float* P = (const float*)(p.ws + WS_S5P) + (size_t)layer * S5P_L;
    K.ar = P[(g * 64 + lane) * 2]; K.ai = P[(g * 64 + lane) * 2 + 1];
#pragma unroll
    for (int c = 0; c < 16; ++c) { K.bre[c] = P[8192 + ((g * 16 + c) * 64 + lane) * 2]; K.bim[c] = P[8192 + ((g * 16 + c) * 64 + lane) * 2 + 1]; }
    K.dd = 0.f;
    if (FINAL) {
        const float* cre = p.in[18] + ((size_t)(layer * 32 + g) * 16 + fr) * 64; const float* cim = p.in[19] + ((size_t)(layer * 32 + g) * 16 + fr) * 64;
#pragma unroll
        for (int kk = 0; kk < 4; ++kk) { bf16x8 t;
#pragma unroll
            for (int j = 0; j < 8; ++j) { const int k = (kk & 1) * 32 + fq * 8 + j; t[j] = (short)f2bf(kk < 2 ? cre[k] : -cim[k]); }
            K.cmb[kk] = t; }
        K.dd = p.in[20][layer * 512 + g * 16 + fr];
    }
}
template <bool FINAL> __device__ __forceinline__ void s5_item(const Params& p, LAS unsigned char* ldsw, int item, int layer, const bf16_t* proj, const S5Coef& K) {
    const int lane = otid() & 63, fr = lane & 15, fq = lane >> 4;
    const int g = item & 31, bn = item >> 5, n = bn % NCH, b = bn / NCH;
    LAS float* us = (LAS float*)ldsw;
    LAS bf16_t* Sb = (LAS bf16_t*)(us + 64 * 20);
    const size_t pos0 = (size_t)b * LP + (size_t)n * 64;
    { const bf16_t* src = proj + (pos0 + lane) * PW + 1792 + g * 16;
      const u32x4 v0 = *(const u32x4*)src, v1 = *(const u32x4*)(src + 8);
      LAS float* d = us + lane * 20;
      d[0] = bflo(v0.x); d[1] = bfhi(v0.x); d[2] = bflo(v0.y); d[3] = bfhi(v0.y); d[4] = bflo(v0.z); d[5] = bfhi(v0.z); d[6] = bflo(v0.w); d[7] = bfhi(v0.w);
      d[8] = bflo(v1.x); d[9] = bfhi(v1.x); d[10] = bflo(v1.y); d[11] = bfhi(v1.y); d[12] = bflo(v1.z); d[13] = bfhi(v1.z); d[14] = bflo(v1.w); d[15] = bfhi(v1.w); }
    float* E = (float*)(p.ws + WS_E);
    float sr = 0.f, si = 0.f;
    if (FINAL) { const float* c = (const float*)(p.ws + WS_CIN) + ((size_t)((b * NCH + n) * 32 + g) * 64 + lane) * 2; sr = c[0]; si = c[1]; }
    WAVE_LDS_SYNC();
    bf16_t* YG = (bf16_t*)(p.ws + WS_XN);
    for (int t = 0; t < 64; ++t) {
        float br0 = 0.f, bi0 = 0.f, br1 = 0.f, bi1 = 0.f;
        { const f32x4 ua = *(const LAS f32x4*)(us + t * 20), ub = *(const LAS f32x4*)(us + t * 20 + 4), uc = *(const LAS f32x4*)(us + t * 20 + 8), ud = *(const LAS f32x4*)(us + t * 20 + 12);
#pragma unroll
          for (int c = 0; c < 4; ++c) { br0 += K.bre[c] * ua[c]; bi0 += K.bim[c] * ua[c]; br1 += K.bre[8 + c] * uc[c]; bi1 += K.bim[8 + c] * uc[c]; }
#pragma unroll
          for (int c = 0; c < 4; ++c) { br0 += K.bre[4 + c] * ub[c]; bi0 += K.bim[4 + c] * ub[c]; br1 += K.bre[12 + c] * ud[c]; bi1 += K.bim[12 + c] * ud[c]; } }
        const float nr = K.ar * sr - K.ai * si + (br0 + br1), ni = K.ar * si + K.ai * sr + (bi0 + bi1); sr = nr; si = ni;
        if (FINAL) {
            Sb[(t & 15) * 136 + lane] = f2bf(sr); Sb[(t & 15) * 136 + 64 + lane] = f2bf(si);
            if ((t & 15) == 15) {
                WAVE_LDS_SYNC();
                f32x4 y = (f32x4){0.f, 0.f, 0.f, 0.f};
#pragma unroll
                for (int kk = 0; kk < 4; ++kk) { const bf16x8 sa = *(const LAS bf16x8*)(Sb + fr * 136 + kk * 32 + fq * 8); y = mfma16(sa, K.cmb[kk], y); }
#pragma unroll
                for (int r = 0; r < 4; ++r) { const int tl = (t - 15) + fq * 4 + r;
                    const float yv = y[r] + K.dd * us[tl * 20 + fr];
                    const float x = 0.7978845608f * (yv + 0.044715f * yv * yv * yv);
                    const float th = 1.f - 2.f * __builtin_amdgcn_rcpf(1.f + __expf(2.f * x));
                    YG[(pos0 + tl) * 512 + g * 16 + fr] = f2bf(0.5f * yv * (1.f + th)); }
                WAVE_LDS_SYNC();
            }
        }
    }
    if (!FINAL) { float* e = E + ((size_t)((b * NCH + n) * 32 + g) * 64 + lane) * 2; e[0] = sr; e[1] = si; }
}

__device__ __forceinline__ void s5_carry_scan(const Params& p, int layer) {
    const int tid = otid(), lane = tid & 63, gw = obid() * 8 + (tid >> 6);
    if (gw >= 64) return;
    const int b = gw >> 5, g = gw & 31;
    const float* P = (const float*)(p.ws + WS_S5P) + (size_t)layer * S5P_L;
    const float a64r = P[4096 + (g * 64 + lane) * 2], a64i = P[4096 + (g * 64 + lane) * 2 + 1];
    const float* E = (const float*)(p.ws + WS_E); float* C = (float*)(p.ws + WS_CIN);
    float cr = 0.f, ci = 0.f;
    static_assert(NCH % 43 == 0, "chunk groups");
    for (int n0 = 0; n0 < NCH; n0 += 43) {
        float er[43], ei[43];
#pragma unroll
        for (int k = 0; k < 43; ++k) { const float* e = E + ((size_t)((b * NCH + n0 + k) * 32 + g) * 64 + lane) * 2; er[k] = e[0]; ei[k] = e[1]; }
#pragma unroll
        for (int k = 0; k < 43; ++k) { float* c = C + ((size_t)((b * NCH + n0 + k) * 32 + g) * 64 + lane) * 2; c[0] = cr; c[1] = ci;
            const float nr = a64r * cr - a64i * ci + er[k], ni = a64r * ci + a64i * cr + ei[k]; cr = nr; ci = ni; }
    }
}

__device__ __forceinline__ void mix_finalize(const Params& p, int layer, const bf16_t* proj, bf16_t* mixed) {
    const int lane = otid() & 63, wid = otid() >> 6;
    const float* odn = (const float*)((unsigned char*)p.out + DO_ODN);
    const bf16_t* GL = (const bf16_t*)(p.ws + WS_XN) + (size_t)MROWS * 512;
    const float* gdn = p.in[12] + layer * 64; const float* gs5 = p.in[23] + layer * 512;
    for (int row = obid() * 8 + wid; row < MROWS; row += gridDim.x * 8) {
        { const f32x4 v = *(const f32x4*)(odn + (size_t)row * 256 + lane * 4);
          float ss = v[0] * v[0] + v[1] * v[1] + v[2] * v[2] + v[3] * v[3];
#pragma unroll
          for (int d = 1; d < 16; d <<= 1) ss += __shfl_xor(ss, d, 16);
          const float rstd = rsqrtf(ss * (1.f / 64.f) + 1e-6f);
          const u32x2 zz = *(const u32x2*)(proj + (size_t)row * PW + 1536 + lane * 4);
          const f32x4 gg = *(const f32x4*)(gdn + (lane & 15) * 4);
          u32x2 w; w.x = pack2(v[0] * rstd * gg[0] * silu_fast(bflo(zz.x)), v[1] * rstd * gg[1] * silu_fast(bfhi(zz.x)));
          w.y = pack2(v[2] * rstd * gg[2] * silu_fast(bflo(zz.y)), v[3] * rstd * gg[3] * silu_fast(bfhi(zz.y)));
          *(u32x2*)(mixed + (size_t)row * DM + 256 + lane * 4) = w; }
        { const u32x4 gv = *(const u32x4*)(GL + (size_t)row * 512 + lane * 8);
          float v[8] = {bflo(gv.x), bfhi(gv.x), bflo(gv.y), bfhi(gv.y), bflo(gv.z), bfhi(gv.z), bflo(gv.w), bfhi(gv.w)};
          float ss = 0.f;
#pragma unroll
          for (int j = 0; j < 8; ++j) ss += v[j] * v[j];
#pragma unroll
          for (int d = 1; d < 64; d <<= 1) ss += __shfl_xor(ss, d);
          const float rstd = rsqrtf(ss * (1.f / 512.f) + 1e-6f);
          const f32x4 g0 = *(const f32x4*)(gs5 + lane * 8), g1 = *(const f32x4*)(gs5 + lane * 8 + 4);
          u32x4 w; w.x = pack2(v[0] * rstd * g0[0], v[1] * rstd * g0[1]); w.y = pack2(v[2] * rstd * g0[2], v[3] * rstd * g0[3]);
          w.z = pack2(v[4] * rstd * g1[0], v[5] * rstd * g1[1]); w.w = pack2(v[6] * rstd * g1[2], v[7] * rstd * g1[3]);
          *(u32x4*)(mixed + (size_t)row * DM + 512 + lane * 8) = w; }
    }
}

constexpr int NPHASE = 29;
#ifndef ALIGN_UP
#define ALIGN_UP true
#endif
#ifndef ALIGN_GLU
#define ALIGN_GLU true
#endif
#ifndef ALIGN_IN
#define ALIGN_IN true
#endif
__device__ __forceinline__ void layer_phases(LAS unsigned char* lds, int lo, int hi, int L) {
#define PP() const ParamsG* pp = (const ParamsG*)__builtin_amdgcn_kernarg_segment_ptr(); asm volatile("" : "+s"(pp)); Params pl_; pl_.ws = (unsigned char*)pp->ws; pl_.out = (float*)pp->out; _Pragma("unroll") for (int i_ = 0; i_ < 30; ++i_) pl_.in[i_] = (const float*)pp->in[i_]; const Params& p = pl_; \
    float* H = (float*)(p.ws + WS_H); bf16_t* XN = (bf16_t*)(p.ws + WS_XN); bf16_t* ACT = (bf16_t*)(p.ws + WS_BIG); bf16_t* PROJ = (bf16_t*)(p.ws + WS_BIG); \
    bf16_t* MIXED = (bf16_t*)(p.ws + WS_BIG + SZ_PROJ); bf16_t* YG = XN; bf16_t* GL = XN + (size_t)MROWS * 512; const bf16_t* Wl = (const bf16_t*)(p.ws + WS_W) + (size_t)L * WL; \
    (void)H; (void)XN; (void)ACT; (void)PROJ; (void)MIXED; (void)YG; (void)GL; (void)Wl;
#define IN(k) (lo <= (k) && (k) < hi)
#define SEAM(k) do { if ((k) + 1 < hi) { if ((k) == 0) cg::this_grid().sync(); else { const ParamsG* pq = (const ParamsG*)__builtin_amdgcn_kernarg_segment_ptr(); asm volatile("" : "+s"(pq)); \
        XcdBarrier xb_; xb_.bar = (unsigned*)(unsigned char*)(pq->ws + WS_BAR); xb_.x = xb_xcc_id(); xb_.st = (volatile LAS unsigned*)(lds + 131072); xcd_barrier(xb_); } } } while (0)
    const int pb = 1 + 14 * L;
    if (IN(pb + 0)) { { PP(); EpiSwiGLU E{ACT}; run_gemm<EpiSwiGLU, ALIGN_UP>(lds, XN, Wl + WO_GU1, 2 * DFF, DM, E); } SEAM(pb + 0); }
    if (IN(pb + 1)) { { PP(); run_gemm_resid(lds, ACT, Wl + WO_D1, DM, DFF, H, 0.5f); } SEAM(pb + 1); }
    if (IN(pb + 2)) { { PP(); norm_rows<1>(p, lds, p.in[6] + L * DM, L); } SEAM(pb + 2); }
    if (IN(pb + 3)) { { PP(); EpiBf16 E{PROJ, PW}; run_gemm<EpiBf16, ALIGN_IN>(lds, XN, Wl + WO_IN, PW, DM, E); } SEAM(pb + 3); }
    if (IN(pb + 4)) { { PP(); const int wid = otid() >> 6;
        const DNBufs D = dn_bufs(p);
        int it = obid();
        for (; it < NDN; it += gridDim.x) dn_local_item(p, lds, it, L, PROJ, D);
        if (it < NDN + NDN) {
            S5Coef K; int gk = ((it - NDN) * 8 + wid) & 31; s5_load_coef<false>(p, L, gk, K);
            for (; it < NDN + NDN; it += gridDim.x) { const int item = (it - NDN) * 8 + wid;
                if ((item & 31) != gk) { gk = item & 31; s5_load_coef<false>(p, L, gk, K); }
                s5_item<false>(p, lds + wid * 9472, item, L, PROJ, K); __syncthreads(); } } }
        SEAM(pb + 4); }
    if (IN(pb + 5)) { { PP(); s5_carry_scan(p, L); } SEAM(pb + 5); }
    if (IN(pb + 6)) { { PP(); const int wid = otid() >> 6;
        const DNBufs D = dn_bufs(p);
        if (obid() < 8) dn_seq_block(lds, obid(), D);
        else { int it = obid() - 8;
            for (; it < 8 * NQB; it += gridDim.x - 8) sb_item(lds, it, PROJ, MIXED, p.in[8] + L * 64);
            if (it < 8 * NQB + NDN) {
                S5Coef K; int gk = ((it - 8 * NQB) * 8 + wid) & 31; s5_load_coef<true>(p, L, gk, K);
                for (; it < 8 * NQB + NDN; it += gridDim.x - 8) { const int item = (it - 8 * NQB) * 8 + wid;
                    if ((item & 31) != gk) { gk = item & 31; s5_load_coef<true>(p, L, gk, K); }
                    s5_item<true>(p, lds + wid * 9472, item, L, PROJ, K); __syncthreads(); } } } }
        SEAM(pb + 6); }
    if (IN(pb + 7)) { { PP(); EpiGLU E{YG, GL, p.in[22] + L * 512}; run_gemm<EpiGLU, ALIGN_GLU>(lds, YG, Wl + WO_GLU, 512, 512, E); } SEAM(pb + 7); }
    if (IN(pb + 8)) { { PP(); mix_finalize(p, L, PROJ, MIXED); } SEAM(pb + 8); }
    if (IN(pb + 9)) { { PP(); run_gemm_resid(lds, MIXED, Wl + WO_OUT, DM, DM, H, 1.0f); } SEAM(pb + 9); }
    if (IN(pb + 10)) { { PP(); norm_rows<0>(p, lds, p.in[25] + L * DM, L); } SEAM(pb + 10); }
    if (IN(pb + 11)) { { PP(); EpiSwiGLU E{ACT}; run_gemm<EpiSwiGLU, ALIGN_UP>(lds, XN, Wl + WO_GU2, 2 * DFF, DM, E); } SEAM(pb + 11); }
    if (IN(pb + 12)) { { PP(); run_gemm_resid(lds, ACT, Wl + WO_D2, DM, DFF, H, 0.5f); } SEAM(pb + 12); }
    if (IN(pb + 13)) { { PP(); if (L == 0) norm_rows<0>(p, lds, p.in[2] + DM, 1); else norm_rows<2>(p, lds, p.in[29], 1); } SEAM(pb + 13); }
}
__global__ void __launch_bounds__(NTHR, 2) hymba_fwd(Params p_arg) {
    extern __shared__ __attribute__((aligned(16))) unsigned char smem[];
    LAS unsigned char* lds = (LAS unsigned char*)smem;
    const int lo = p_arg.ph_lo, hi = p_arg.ph_hi;
    if (otid() < 4) ((LAS unsigned*)(lds + 131072))[otid()] = 0u;
    __syncthreads();
    (void)xcd_barrier_post((unsigned*)as_global(p_arg.ws + WS_BAR), (volatile LAS unsigned*)(lds + 131072));
    constexpr int L = 0;
    if (IN(0)) { { PP(); convert_weights(p, lds); s5_params(p); norm_rows<3>(p, lds, p.in[2], 0); } SEAM(0); }
#pragma nounroll
    for (int l = 0; l < 2; ++l) { int lq = l; asm volatile("" : "+s"(lq)); layer_phases(lds, lo, hi, lq); }
#undef IN
#undef SEAM
#undef PP
}

extern "C" void kernel_launch(void* const* d_in, const int* in_sizes, int n_in, void* d_out, int out_size, void* d_ws, size_t ws_size, hipStream_t stream) {
    static int grid = 0;
    if (grid == 0) {
        if (n_in != 30 || ws_size < WS_END) { fprintf(stderr, "kernel_launch: unexpected n_in %d or ws_size %zu (need %zu)\n", n_in, ws_size, (size_t)WS_END); grid = -1; return; }
        int dev = 0, cus = 0, per_cu = 0;
        hipGetDevice(&dev);
        hipDeviceGetAttribute(&cus, hipDeviceAttributeMultiprocessorCount, dev);
        if (hipFuncSetAttribute((const void*)hymba_fwd, hipFuncAttributeMaxDynamicSharedMemorySize, LDS_BYTES) != hipSuccess) { fprintf(stderr, "kernel_launch: hipFuncSetAttribute failed\n"); grid = -1; return; }
        if (hipOccupancyMaxActiveBlocksPerMultiprocessor(&per_cu, (const void*)hymba_fwd, NTHR, LDS_BYTES) != hipSuccess || per_cu < 1) { fprintf(stderr, "kernel_launch: occupancy query gave %d\n", per_cu); per_cu = 1; }
        (void)hipGetLastError();
        grid = cus * 1;
        fprintf(stderr, "kernel_launch: cus %d per_cu %d grid %d ws %zu\n", cus, per_cu, grid, ws_size);
    }
    if (grid < 0) return;
    (void)hipMemsetAsync((unsigned char*)d_ws + WS_BAR, 0, SZ_BAR, stream);
    Params p{};
    for (int i = 0; i < 30; ++i) p.in[i] = (const float*)d_in[i];
    p.out = (float*)d_out; p.ws = (unsigned char*)d_ws;
#if SINGLE_LAUNCH
    p.ph_lo = 0; p.ph_hi = NPHASE;
    void* args[] = {&p};
    hipError_t e = hipLaunchCooperativeKernel((const void*)hymba_fwd, dim3(grid), dim3(NTHR), args, LDS_BYTES, stream);
    if (e != hipSuccess) fprintf(stderr, "cooperative launch failed: %s (grid %d)\n", hipGetErrorString(e), grid);
#else
    for (int ph = 0; ph < NPHASE; ++ph) {
        p.ph_lo = ph; p.ph_hi = ph + 1;
        hipLaunchKernelGGL(hymba_fwd, dim3(grid), dim3(NTHR), LDS_BYTES, stream, p);
    }
#endif
}
```

```cpp
#include <hip/hip_runtime.h>
#include <hip/hip_cooperative_groups.h>
#include <cstdio>
namespace cg = cooperative_groups;

#ifndef SINGLE_LAUNCH
#define SINGLE_LAUNCH 1
#endif

__device__ __forceinline__ int otid() { int t = threadIdx.x; asm volatile("" : "+v"(t)); return t; }
__device__ __forceinline__ int obid() { int b = blockIdx.x; asm volatile("" : "+s"(b)); return b; }
namespace pg8 {
#define PG8_LAS __attribute__((address_space(3)))
typedef unsigned short bf16_t;
typedef short bf16x8 __attribute__((ext_vector_type(8)));
typedef float f32x4 __attribute__((ext_vector_type(4)));
typedef unsigned u32x4 __attribute__((ext_vector_type(4)));
constexpr int BM = 256, BK = 64, HALF = 128, HTB = HALF * BK * 2  , STAGE_BYTES = 8 * HTB, NXCD = 8, WGM = 4;

__host__ __device__ __forceinline__ int lds_byte(int r, int c) { const int st = (r >> 4) * 2 + (c >> 5), rr = r & 15, cc = c & 31, ob = rr * 64 + cc * 2; return st * 1024 + (ob ^ (((ob >> 9) & 1) << 5)); }
__host__ __device__ __forceinline__ void stage_rc(int b, int& R, int& C) { const int st = b / 1024, sb = b % 1024, swz = sb ^ (((sb >> 9) & 1) << 5); R = (st >> 1) * 16 + swz / 64; C = (st & 1) * 32 + (swz % 64) / 2; }
__host__ __device__ __forceinline__ int perm32(int rho) { const int n = rho >> 4, i = rho & 15; return 8 * (i >> 2) + 4 * n + (i & 3); }

struct Unit { int pm, pn, kp; };
struct Gemm { const bf16_t* A; const bf16_t* Bt; int M, N, K, ld; };

struct StaticOrder {
    int nM, nN, nwg, G, c;
    __host__ __device__ void init(int M, int N, int G_, int c_) { nM = M / BM; nN = N / BM; nwg = nM * nN; G = G_; c = c_; }
    __host__ __device__ bool next(int i, Unit& u) const {
        const long L = (long)i * G + c; if (L >= nwg) return false;
        int wgid = (int)L; { const int q = nwg / NXCD, r = nwg % NXCD, xcd = wgid % NXCD, off = wgid / NXCD; wgid = (xcd < r ? xcd * (q + 1) : r * (q + 1) + (xcd - r) * q) + off; }
        const int nig = WGM * nN, gid = wgid / nig, fm = gid * WGM, gsz = (nM - fm) < WGM ? (nM - fm) : WGM;
        u.pm = fm + ((wgid % nig) % gsz); u.pn = (wgid % nig) / gsz; u.kp = 0; return true;
    }
    __device__ __forceinline__ void a_ready(const Unit&) const {}
    __device__ __forceinline__ void done(const Unit&) const {}
};
struct HeadOrder : StaticOrder {
    int nfull;
    __host__ __device__ void init2(int M, int N, int G_, int c_) { init(M, N, G_, c_); nfull = (nwg / G_) * G_; }
    __host__ __device__ bool next(int i, Unit& u) const { if ((long)i * G + c >= nfull) return false; return StaticOrder::next(i, u); }
};
struct TailOrder : StaticOrder {
    int nfull, np;
    __host__ __device__ void init2(int M, int N, int G_, int c_, int np_) { init(M, N, G_, c_); nfull = (nwg / G_) * G_; np = np_; }
    __host__ __device__ bool next(int i, Unit& u) const {
        if (i > 0) return false;
        const int t = nfull + c / np; if (t >= nwg) return false;
        StaticOrder s2 = *this; s2.c = t % G; if (!s2.StaticOrder::next(t / G, u)) return false;
        u.kp = c % np; return true;
    }
};
__device__ __forceinline__ unsigned cvt_pk_bf16(float lo, float hi) { unsigned r; asm volatile("v_cvt_pk_bf16_f32 %0, %1, %2" : "=v"(r) : "v"(lo), "v"(hi)); return r; }
template <class Epi, class Sched, bool STAMP = false>
__device__ __forceinline__ void gemm_phase(PG8_LAS unsigned char* lds, const Gemm g, const Sched& S, const Epi& E, unsigned long long* stamps) {
    const int tid = otid(), wid = __builtin_amdgcn_readfirstlane(tid >> 6), lane = tid & 63, wr = wid >> 2, wc = wid & 3, fr = lane & 15, fq = lane >> 4;
    const int K = g.K, nt = K / BK, ld = g.ld;
    unsigned voffA[2], voffB[2];
#pragma unroll
    for (int i = 0; i < 2; ++i) { int R, C; stage_rc(tid * 16 + i * 8192, R, C); const int Rb = E.perm() ? ((R & ~31) + perm32(R & 31)) : R;
        voffA[i] = (unsigned)(R * ld + C) * 2u; voffB[i] = (unsigned)(Rb * ld + C) * 2u; }
    const size_t kstep = (size_t)(BK * 2);
    const size_t hstep = (size_t)HALF * ld * 2;
    const size_t tstep = 2 * hstep;
    const unsigned ldsw = (unsigned)wid * 1024u;
    const int aoff = lds_byte(wr * 64 + fr, fq * 8), boff = lds_byte(wc * 32 + fr, fq * 8);
#define PG8_SA(b, h) (((b) * 2 + (h)) * HTB)
#define PG8_SB(b, h) ((4 + (b) * 2 + (h)) * HTB)
#define PG8_STAGE(bufoff, gbase, voff) do { _Pragma("unroll") for (int _i = 0; _i < 2; ++_i) \
        __builtin_amdgcn_global_load_lds((const unsigned*)((const char*)(gbase) + (voff)[_i]), (PG8_LAS unsigned*)(lds + (bufoff) + ldsw + _i * 8192), 16, 0, 0); } while (0)
#define PG8_LDA(dst, b, h) do { _Pragma("unroll") for (int m = 0; m < 4; ++m) _Pragma("unroll") for (int k = 0; k < 2; ++k) dst[m][k] = *(const PG8_LAS bf16x8*)(lds + PG8_SA(b, h) + aoff + m * 2048 + k * 1024); } while (0)
#define PG8_LDB(dst, b, h) do { _Pragma("unroll") for (int n = 0; n < 2; ++n) _Pragma("unroll") for (int k = 0; k < 2; ++k) dst[n][k] = *(const PG8_LAS bf16x8*)(lds + PG8_SB(b, h) + boff + n * 2048 + k * 1024); } while (0)
#define PG8_MMA(ai, bj, At, Bt) do { __builtin_amdgcn_s_setprio(1); _Pragma("unroll") for (int m = 0; m < 4; ++m) _Pragma("unroll") for (int n = 0; n < 2; ++n) _Pragma("unroll") for (int k = 0; k < 2; ++k) \
        acc[ai][bj][m][n] = __builtin_amdgcn_mfma_f32_16x16x32_bf16(Bt[n][k], At[m][k], acc[ai][bj][m][n], 0, 0, 0); __builtin_amdgcn_s_setprio(0); } while (0)
#define PG8_WAIT_V(n) asm volatile("s_waitcnt vmcnt(" #n ")" ::: "memory")
#define PG8_WAIT_L(n) asm volatile("s_waitcnt lgkmcnt(" #n ")" ::: "memory")
#define PG8_BAR __builtin_amdgcn_s_barrier()
#define PG8_SCHED __builtin_amdgcn_sched_barrier(0)
    Unit cur, nxt; int ui = 0;
    if (!S.next(0, cur)) return;
    f32x4 acc[2][2][4][2];
#pragma unroll
    for (int a = 0; a < 2; ++a)
#pragma unroll
        for (int b = 0; b < 2; ++b)
#pragma unroll
            for (int m = 0; m < 4; ++m)
#pragma unroll
                for (int n = 0; n < 2; ++n) acc[a][b][m][n] = (f32x4){0.f, 0.f, 0.f, 0.f};
    bf16x8 At[4][2], B0[2][2], B1[2][2];
    const char* cA = (const char*)g.A + (size_t)cur.pm * tstep + (size_t)cur.kp * K * 2; const char* cB = (const char*)g.Bt + (size_t)cur.pn * tstep + (size_t)cur.kp * K * 2;
    S.a_ready(cur);
    PG8_STAGE(PG8_SB(0, 0), cB, voffB); PG8_STAGE(PG8_SA(0, 0), cA, voffA); PG8_STAGE(PG8_SB(0, 1), cB + hstep, voffB); PG8_STAGE(PG8_SA(0, 1), cA + hstep, voffA);
    if (wr == 1) PG8_BAR;
    PG8_WAIT_V(4); PG8_BAR;
    PG8_STAGE(PG8_SB(1, 0), cB + kstep, voffB); PG8_STAGE(PG8_SA(1, 0), cA + kstep, voffA); PG8_STAGE(PG8_SB(1, 1), cB + hstep + kstep, voffB);
    PG8_WAIT_V(6); PG8_BAR;
    for (;;) {
        const bool has_next = S.next(ui + 1, nxt);
        const char* nA = has_next ? (const char*)g.A + (size_t)nxt.pm * tstep + (size_t)nxt.kp * K * 2 : cA; const char* nB = has_next ? (const char*)g.Bt + (size_t)nxt.pn * tstep + (size_t)nxt.kp * K * 2 : cB;
        for (int t = 0; t < nt; t += 2) {
            const bool last = (t == nt - 2);
            const char* a1 = cA + (size_t)(t + 1) * kstep;
            const char* a2 = last ? nA : cA + (size_t)(t + 2) * kstep; const char* b2 = last ? nB : cB + (size_t)(t + 2) * kstep;
            const char* a3 = a2 + kstep; const char* b3 = b2 + kstep;
            if (last && has_next) S.a_ready(nxt);
            PG8_LDB(B0, 0, 0); PG8_SCHED; PG8_LDA(At, 0, 0); PG8_STAGE(PG8_SA(1, 1), a1 + hstep, voffA);
            PG8_WAIT_L(8); PG8_BAR; PG8_WAIT_L(0); PG8_MMA(0, 0, At, B0); PG8_BAR; PG8_SCHED;
            PG8_LDB(B1, 0, 1); PG8_STAGE(PG8_SB(0, 0), b2, voffB);
            PG8_BAR; PG8_WAIT_L(0); PG8_MMA(0, 1, At, B1); PG8_BAR;
            PG8_LDA(At, 0, 1); PG8_STAGE(PG8_SA(0, 0), a2, voffA);
            PG8_BAR; PG8_WAIT_L(0); PG8_MMA(1, 0, At, B0); PG8_BAR; PG8_SCHED;
            PG8_STAGE(PG8_SB(0, 1), b2 + hstep, voffB);
            PG8_WAIT_V(6); PG8_BAR; PG8_MMA(1, 1, At, B1); PG8_BAR;
            PG8_LDB(B0, 1, 0); PG8_SCHED; PG8_LDA(At, 1, 0); PG8_STAGE(PG8_SA(0, 1), a2 + hstep, voffA);
            PG8_WAIT_L(8); PG8_BAR; PG8_WAIT_L(0); PG8_MMA(0, 0, At, B0); PG8_BAR; PG8_SCHED;
            PG8_LDB(B1, 1, 1); PG8_STAGE(PG8_SB(1, 0), b3, voffB);
            PG8_BAR; PG8_WAIT_L(0); PG8_MMA(0, 1, At, B1); PG8_BAR;
            PG8_LDA(At, 1, 1); PG8_STAGE(PG8_SA(1, 0), a3, voffA);
            PG8_BAR; PG8_WAIT_L(0); PG8_MMA(1, 0, At, B0); PG8_BAR; PG8_SCHED;
            PG8_STAGE(PG8_SB(1, 1), b3 + hstep, voffB);
            PG8_WAIT_V(6); PG8_BAR; PG8_MMA(1, 1, At, B1); PG8_BAR;
        }
        if constexpr (!Epi::AFTER_DRAIN) { E(acc, cur, wr, wc, fr, fq); S.done(cur); }
        if (!has_next) break;
#pragma unroll
        for (int a = 0; a < 2; ++a)
#pragma unroll
            for (int b = 0; b < 2; ++b)
#pragma unroll
                for (int m = 0; m < 4; ++m)
#pragma unroll
                    for (int n = 0; n < 2; ++n) acc[a][b][m][n] = (f32x4){0.f, 0.f, 0.f, 0.f};
        cur = nxt; cA = nA; cB = nB; ++ui;
    }
    PG8_WAIT_V(0);
    if (wr == 0) PG8_BAR;
    PG8_BAR;
    if constexpr (Epi::AFTER_DRAIN) { E.fused(acc, cur, wr, wc, fr, fq, lds, wid, lane); S.done(cur); }
#undef PG8_SA
#undef PG8_SB
#undef PG8_STAGE
#undef PG8_LDA
#undef PG8_LDB
#undef PG8_MMA
#undef PG8_WAIT_V
#undef PG8_WAIT_L
#undef PG8_BAR
#undef PG8_SCHED
}
template <class Epi, class Sched, bool ALIGN_EPI = false, bool SP2 = false>
__device__ __forceinline__ void gemm_phase2(PG8_LAS unsigned char* lds, const Gemm g, const Sched& S, const Epi& E) {
    const int tid = otid(), wid = __builtin_amdgcn_readfirstlane(tid >> 6), lane = tid & 63, wr = wid >> 2, wc = wid & 3, fr = lane & 15, fq = lane >> 4;
    const int K = g.K, nt = K / BK, ld = g.ld;
    unsigned voffA[2], voffB[2];
#pragma unroll
    for (int i = 0; i < 2; ++i) { int R, C; stage_rc(tid * 16 + i * 8192, R, C); const int Rb = E.perm() ? ((R & ~31) + perm32(R & 31)) : R;
        voffA[i] = (unsigned)(R * ld + C) * 2u; voffB[i] = (unsigned)(Rb * ld + C) * 2u; }
    const size_t kstep = (size_t)(BK * 2);
    const size_t hstep = (size_t)HALF * ld * 2;
    const size_t tstep = 2 * hstep;
    const unsigned ldsw = (unsigned)wid * 1024u;
    const int aoff = lds_byte(wr * 64 + fr, fq * 8), boff = lds_byte(wc * 32 + fr, fq * 8);
#define PG8_SA(b, h) (((b) * 2 + (h)) * HTB)
#define PG8_SB(b, h) ((4 + (b) * 2 + (h)) * HTB)
#define PG8_STAGE(bufoff, gbase, voff) do { _Pragma("unroll") for (int _i = 0; _i < 2; ++_i) \
        __builtin_amdgcn_global_load_lds((const unsigned*)((const char*)(gbase) + (voff)[_i]), (PG8_LAS unsigned*)(lds + (bufoff) + ldsw + _i * 8192), 16, 0, 0); } while (0)
#define PG8_LDA(dst, b, h) do { _Pragma("unroll") for (int m = 0; m < 4; ++m) _Pragma("unroll") for (int k = 0; k < 2; ++k) dst[m][k] = *(const PG8_LAS bf16x8*)(lds + PG8_SA(b, h) + aoff + m * 2048 + k * 1024); } while (0)
#define PG8_LDB(dst, b, h) do { _Pragma("unroll") for (int n = 0; n < 2; ++n) _Pragma("unroll") for (int k = 0; k < 2; ++k) dst[n][k] = *(const PG8_LAS bf16x8*)(lds + PG8_SB(b, h) + boff + n * 2048 + k * 1024); } while (0)
#define PG8_MMA(ai, bj, At, Bt) do { __builtin_amdgcn_s_setprio(1); _Pragma("unroll") for (int m = 0; m < 4; ++m) _Pragma("unroll") for (int n = 0; n < 2; ++n) _Pragma("unroll") for (int k = 0; k < 2; ++k) \
        acc[ai][bj][m][n] = __builtin_amdgcn_mfma_f32_16x16x32_bf16(Bt[n][k], At[m][k], acc[ai][bj][m][n], 0, 0, 0); __builtin_amdgcn_s_setprio(0); } while (0)
#define PG8_WAIT_V(n) asm volatile("s_waitcnt vmcnt(" #n ")" ::: "memory")
#define PG8_WAIT_L(n) asm volatile("s_waitcnt lgkmcnt(" #n ")" ::: "memory")
#define PG8_BAR __builtin_amdgcn_s_barrier()
#define PG8_SCHED __builtin_amdgcn_sched_barrier(0)
    Unit cur, nxt; int ui = 0;
    if (!S.next(0, cur)) return;
    f32x4 acc[2][2][4][2];
#pragma unroll
    for (int a = 0; a < 2; ++a)
#pragma unroll
        for (int b = 0; b < 2; ++b)
#pragma unroll
            for (int m = 0; m < 4; ++m)
#pragma unroll
                for (int n = 0; n < 2; ++n) acc[a][b][m][n] = (f32x4){0.f, 0.f, 0.f, 0.f};
    bf16x8 At[4][2], B0[2][2], B1[2][2];
    const char* cA = (const char*)g.A + (size_t)cur.pm * tstep + (size_t)cur.kp * K * 2; const char* cB = (const char*)g.Bt + (size_t)cur.pn * tstep + (size_t)cur.kp * K * 2;
    S.a_ready(cur);
    if constexpr (SP2) {
        PG8_STAGE(PG8_SB(0, 0), cB, voffB); PG8_STAGE(PG8_SB(0, 1), cB + hstep, voffB); PG8_STAGE(PG8_SA(0, 0), cA, voffA); PG8_STAGE(PG8_SA(0, 1), cA + hstep, voffA);
        if (wr == 1) PG8_BAR;
        PG8_WAIT_V(2); PG8_BAR;
        PG8_STAGE(PG8_SB(1, 0), cB + kstep, voffB); PG8_STAGE(PG8_SA(1, 0), cA + kstep, voffA); PG8_STAGE(PG8_SB(1, 1), cB + hstep + kstep, voffB);
        PG8_WAIT_V(6); PG8_BAR;
    } else {
        PG8_STAGE(PG8_SB(0, 0), cB, voffB); PG8_STAGE(PG8_SA(0, 0), cA, voffA); PG8_STAGE(PG8_SB(0, 1), cB + hstep, voffB); PG8_STAGE(PG8_SA(0, 1), cA + hstep, voffA);
        if (wr == 1) PG8_BAR;
        PG8_WAIT_V(4); PG8_BAR;
        PG8_STAGE(PG8_SB(1, 0), cB + kstep, voffB); PG8_STAGE(PG8_SA(1, 0), cA + kstep, voffA); PG8_STAGE(PG8_SB(1, 1), cB + hstep + kstep, voffB);
        PG8_WAIT_V(6); PG8_BAR;
    }
    for (;;) {
        const bool has_next = S.next(ui + 1, nxt);
        const char* nA = has_next ? (const char*)g.A + (size_t)nxt.pm * tstep + (size_t)nxt.kp * K * 2 : cA; const char* nB = has_next ? (const char*)g.Bt + (size_t)nxt.pn * tstep + (size_t)nxt.kp * K * 2 : cB;
        for (int t = 0; t < nt; t += 2) {
            const bool last = (t == nt - 2);
            const char* a1 = cA + (size_t)(t + 1) * kstep;
            const char* a2 = last ? nA : cA + (size_t)(t + 2) * kstep; const char* b2 = last ? nB : cB + (size_t)(t + 2) * kstep;
            const char* a3 = a2 + kstep; const char* b3 = b2 + kstep;
            if (last && has_next) S.a_ready(nxt);
            if constexpr (SP2) {
            PG8_LDB(B0, 0, 0); PG8_LDB(B1, 0, 1); PG8_SCHED; PG8_LDA(At, 0, 0); PG8_STAGE(PG8_SA(1, 1), a1 + hstep, voffA);
            PG8_WAIT_V(8); PG8_WAIT_L(0); PG8_BAR; PG8_MMA(0, 0, At, B0); PG8_MMA(0, 1, At, B1); PG8_BAR; PG8_SCHED;
            PG8_LDA(At, 0, 1); PG8_STAGE(PG8_SB(0, 0), b2, voffB); PG8_STAGE(PG8_SB(0, 1), b2 + hstep, voffB); PG8_STAGE(PG8_SA(0, 0), a2, voffA);
            PG8_WAIT_V(8); PG8_WAIT_L(0); PG8_BAR; PG8_MMA(1, 0, At, B0); PG8_MMA(1, 1, At, B1); PG8_BAR; PG8_SCHED;
            PG8_LDB(B0, 1, 0); PG8_LDB(B1, 1, 1); PG8_SCHED; PG8_LDA(At, 1, 0); PG8_STAGE(PG8_SA(0, 1), a2 + hstep, voffA);
            PG8_WAIT_V(8); PG8_WAIT_L(0); PG8_BAR; PG8_MMA(0, 0, At, B0); PG8_MMA(0, 1, At, B1); PG8_BAR; PG8_SCHED;
            PG8_LDA(At, 1, 1); PG8_STAGE(PG8_SB(1, 0), b3, voffB); PG8_STAGE(PG8_SB(1, 1), b3 + hstep, voffB); PG8_STAGE(PG8_SA(1, 0), a3, voffA);
            PG8_WAIT_V(8); PG8_WAIT_L(0); PG8_BAR; PG8_MMA(1, 0, At, B0); PG8_MMA(1, 1, At, B1); PG8_BAR; PG8_SCHED;
            } else {
            PG8_LDB(B0, 0, 0); PG8_SCHED; PG8_LDA(At, 0, 0); PG8_STAGE(PG8_SA(1, 1), a1 + hstep, voffA);
            PG8_WAIT_L(8); PG8_BAR; PG8_WAIT_L(0); PG8_MMA(0, 0, At, B0); PG8_BAR; PG8_SCHED;
            PG8_LDB(B1, 0, 1); PG8_STAGE(PG8_SB(0, 0), b2, voffB);
            PG8_BAR; PG8_WAIT_L(0); PG8_MMA(0, 1, At, B1); PG8_BAR;
            PG8_LDA(At, 0, 1); PG8_STAGE(PG8_SA(0, 0), a2, voffA);
            PG8_BAR; PG8_WAIT_L(0); PG8_MMA(1, 0, At, B0); PG8_BAR; PG8_SCHED;
            PG8_STAGE(PG8_SB(0, 1), b2 + hstep, voffB);
            PG8_WAIT_V(6); PG8_BAR; PG8_MMA(1, 1, At, B1); PG8_BAR;
            PG8_LDB(B0, 1, 0); PG8_SCHED; PG8_LDA(At, 1, 0); PG8_STAGE(PG8_SA(0, 1), a2 + hstep, voffA);
            PG8_WAIT_L(8); PG8_BAR; PG8_WAIT_L(0); PG8_MMA(0, 0, At, B0); PG8_BAR; PG8_SCHED;
            PG8_LDB(B1, 1, 1); PG8_STAGE(PG8_SB(1, 0), b3, voffB);
            PG8_BAR; PG8_WAIT_L(0); PG8_MMA(0, 1, At, B1); PG8_BAR;
            PG8_LDA(At, 1, 1); PG8_STAGE(PG8_SA(1, 0), a3, voffA);
            PG8_BAR; PG8_WAIT_L(0); PG8_MMA(1, 0, At, B0); PG8_BAR; PG8_SCHED;
            PG8_STAGE(PG8_SB(1, 1), b3 + hstep, voffB);
            PG8_WAIT_V(6); PG8_BAR; PG8_MMA(1, 1, At, B1); PG8_BAR;
            }
        }
        if constexpr (ALIGN_EPI) { if (wr == 0) PG8_BAR; }
        if constexpr (!Epi::AFTER_DRAIN) { E(acc, cur, wr, wc, fr, fq); S.done(cur); }
        if (!has_next) break;
#pragma unroll
        for (int a = 0; a < 2; ++a)
#pragma unroll
            for (int b = 0; b < 2; ++b)
#pragma unroll
                for (int m = 0; m < 4; ++m)
#pragma unroll
                    for (int n = 0; n < 2; ++n) acc[a][b][m][n] = (f32x4){0.f, 0.f, 0.f, 0.f};
        cur = nxt; cA = nA; cB = nB; ++ui;
        if constexpr (ALIGN_EPI) { if (wr == 1) PG8_BAR; }
    }
    PG8_WAIT_V(0);
    if constexpr (!ALIGN_EPI) { if (wr == 0) PG8_BAR; }
    PG8_BAR;
    if constexpr (Epi::AFTER_DRAIN) { E.fused(acc, cur, wr, wc, fr, fq, lds, wid, lane); S.done(cur); }
#undef PG8_SA
#undef PG8_SB
#undef PG8_STAGE
#undef PG8_LDA
#undef PG8_LDB
#undef PG8_MMA
#undef PG8_WAIT_V
#undef PG8_WAIT_L
#undef PG8_BAR
#undef PG8_SCHED
}
}

#define LAS __attribute__((address_space(3)))
typedef unsigned short bf16_t;
typedef short bf16x8 __attribute__((ext_vector_type(8)));
typedef float f32x4 __attribute__((ext_vector_type(4)));
typedef unsigned u32x4 __attribute__((ext_vector_type(4)));
typedef unsigned u32x2 __attribute__((ext_vector_type(2)));

constexpr int DM = 1024, DFF = 2816, SEQ = 16384, PADF = 112, LP = 16512, MROWS = 33024, PW = 2304, INW = 2312;
constexpr int NCH = 258;
constexpr int NQB = 129;
constexpr int NTHR = 512;
constexpr int LDS_BYTES = 131072 + 16;

constexpr size_t WS_H = 0;
constexpr size_t SZ_H = (size_t)MROWS * DM * 4;
constexpr size_t WS_XN = WS_H + SZ_H;
constexpr size_t SZ_XN = (size_t)MROWS * DM * 2;
constexpr size_t WS_BIG = WS_XN + SZ_XN;
constexpr size_t SZ_PROJ = (size_t)MROWS * PW * 2;
constexpr size_t SZ_BIG = SZ_PROJ + SZ_XN;
constexpr size_t WS_W = WS_BIG + SZ_BIG;
constexpr size_t WL = 20971520;
constexpr size_t SZ_W = WL * 2 * 2;
constexpr size_t WS_BA = WS_W + SZ_W;
constexpr size_t SZ_BA = (size_t)MROWS * 8 * 4;
constexpr size_t WS_E = WS_BA + SZ_BA;
constexpr size_t SZ_E = (size_t)2 * NCH * 32 * 64 * 2 * 4;
constexpr size_t WS_S5P = WS_E + SZ_E;
constexpr size_t S5P_L = 73728;
constexpr size_t SZ_S5P = 2 * S5P_L * 4;
constexpr size_t WS_BAR = WS_S5P + SZ_S5P;
constexpr size_t SZ_BAR = 16384;
constexpr size_t WS_CIN = WS_BAR + SZ_BAR;
constexpr size_t WS_END = WS_CIN + SZ_E;
static_assert(WS_END <= 536870912ull, "workspace too large");
static_assert(SZ_BIG >= (size_t)MROWS * DFF * 2, "act must fit");
constexpr size_t WO_GU1 = 0, WO_D1 = 5767168, WO_IN = 8650752, WO_GLU = 11010048, WO_OUT = 11272192, WO_GU2 = 12320768, WO_D2 = 18087936;
constexpr int NDN = 8 * NCH;
constexpr size_t DO_W = 0, DO_QG = 16908288, DO_ATT = 2 * 16908288ull, DO_KT = 3 * 16908288ull, DO_UT = 4 * 16908288ull, DO_EGL = 5 * 16908288ull;
constexpr size_t DO_ODN = DO_EGL + 8448;
static_assert(DO_ODN + (size_t)MROWS * 256 * 4 <= 134217728ull, "d_out scratch too large");

template <class T> __device__ __forceinline__ T* as_global(T* q) {
#if defined(__HIP_DEVICE_COMPILE__)
    __builtin_assume(!__builtin_amdgcn_is_shared((const __attribute__((address_space(0))) void*)q)); __builtin_assume(!__builtin_amdgcn_is_private((const __attribute__((address_space(0))) void*)q));
#endif
    return q; }
#define GAS __attribute__((address_space(1)))
struct ParamsG { const GAS float* in[30]; GAS float* out; GAS unsigned char* ws; int ph_lo, ph_hi; };
struct Params { const float* in[30]; float* out; unsigned char* ws; int ph_lo, ph_hi; };

typedef float f32x2_t __attribute__((ext_vector_type(2)));
typedef __bf16 bf16x2_t __attribute__((ext_vector_type(2)));
__device__ __forceinline__ unsigned pack2(float lo, float hi) { const f32x2_t v = {lo, hi}; const bf16x2_t b = __builtin_convertvector(v, bf16x2_t); return __builtin_bit_cast(unsigned, b); }
__device__ __forceinline__ bf16_t f2bf(float f) { return (bf16_t)(pack2(f, 0.f) & 0xffffu); }
__device__ __forceinline__ float bf2f(bf16_t b) { return __uint_as_float(((unsigned)b) << 16); }
__device__ __forceinline__ float bflo(unsigned w) { return __uint_as_float(w << 16); }
__device__ __forceinline__ float bfhi(unsigned w) { return __uint_as_float(w & 0xffff0000u); }
__device__ __forceinline__ float softplus_fast(float x) { return fmaxf(x, 0.f) + __logf(1.f + __expf(-fabsf(x))); }
__device__ __forceinline__ float sigmoid_fast(float x) { return __builtin_amdgcn_rcpf(1.f + __expf(-x)); }
__device__ __forceinline__ float silu_fast(float x) { return x * __builtin_amdgcn_rcpf(1.f + __expf(-x)); }
__device__ __forceinline__ f32x4 mfma16(bf16x8 a, bf16x8 b, f32x4 c) { return __builtin_amdgcn_mfma_f32_16x16x32_bf16(a, b, c, 0, 0, 0); }
#define WAVE_LDS_SYNC() do { asm volatile("s_waitcnt lgkmcnt(0)" ::: "memory"); __builtin_amdgcn_wave_barrier(); } while (0)

#ifndef GEMM_SP2
#define GEMM_SP2 true
#endif
#ifndef ALIGN_RES
#define ALIGN_RES true
#endif
#ifndef GEMM_ALIGN
#define GEMM_ALIGN false
#endif
struct EpiSwiGLU {
    static constexpr bool PERM = true, AFTER_DRAIN = false; __device__ __forceinline__ constexpr bool perm() const { return true; }
    bf16_t* O;
    __device__ __forceinline__ void operator()(const f32x4 (&acc)[2][2][4][2], const pg8::Unit& u, int wr, int wc, int fr, int fq) const {
        const int row0 = u.pm * 256 + wr * 64 + fr, j0 = u.pn * 128 + wc * 32 + 8 * fq;
#pragma unroll
        for (int ai = 0; ai < 2; ++ai)
#pragma unroll
            for (int m = 0; m < 4; ++m) {
                const f32x4 g0 = acc[ai][0][m][0], g1 = acc[ai][0][m][1], u0 = acc[ai][1][m][0], u1 = acc[ai][1][m][1];
                u32x4 w;
                w.x = pack2(silu_fast(g0[0]) * u0[0], silu_fast(g0[1]) * u0[1]); w.y = pack2(silu_fast(g0[2]) * u0[2], silu_fast(g0[3]) * u0[3]);
                w.z = pack2(silu_fast(g1[0]) * u1[0], silu_fast(g1[1]) * u1[1]); w.w = pack2(silu_fast(g1[2]) * u1[2], silu_fast(g1[3]) * u1[3]);
                *(u32x4*)(O + (size_t)(row0 + ai * 128 + m * 16) * DFF + j0) = w;
            }
    }
};
struct EpiResid {
    static constexpr bool PERM = false, AFTER_DRAIN = false; __device__ __forceinline__ constexpr bool perm() const { return false; }
    float* H; float scale; int atomic;
    __device__ __forceinline__ void operator()(const f32x4 (&acc)[2][2][4][2], const pg8::Unit& u, int wr, int wc, int fr, int fq) const {
        const int row0 = u.pm * 256 + wr * 64 + fr, col0 = u.pn * 256 + wc * 32 + 4 * fq;
#pragma unroll
        for (int ai = 0; ai < 2; ++ai)
#pragma unroll
            for (int m = 0; m < 4; ++m) { float* rowp = H + (size_t)(row0 + ai * 128 + m * 16) * DM + col0;
#pragma unroll
                for (int bj = 0; bj < 2; ++bj)
#pragma unroll
                    for (int n = 0; n < 2; ++n) { f32x4* q = (f32x4*)(rowp + bj * 128 + n * 16); const f32x4 v = acc[ai][bj][m][n] * scale;
                        if (atomic) { float* qf = (float*)q; unsafeAtomicAdd(qf, v[0]); unsafeAtomicAdd(qf + 1, v[1]); unsafeAtomicAdd(qf + 2, v[2]); unsafeAtomicAdd(qf + 3, v[3]); }
                        else *q = *q + v; } }
    }
};
struct EpiBf16 {
    static constexpr bool PERM = true, AFTER_DRAIN = false; __device__ __forceinline__ constexpr bool perm() const { return true; }
    bf16_t* O; int ldc;
    __device__ __forceinline__ void operator()(const f32x4 (&acc)[2][2][4][2], const pg8::Unit& u, int wr, int wc, int fr, int fq) const {
        const int row0 = u.pm * 256 + wr * 64 + fr, col0 = u.pn * 256 + wc * 32 + 8 * fq;
#pragma unroll
        for (int ai = 0; ai < 2; ++ai)
#pragma unroll
            for (int m = 0; m < 4; ++m) { bf16_t* rowp = O + (size_t)(row0 + ai * 128 + m * 16) * ldc + col0;
#pragma unroll
                for (int bj = 0; bj < 2; ++bj) { const f32x4 v0 = acc[ai][bj][m][0], v1 = acc[ai][bj][m][1];
                    u32x4 w; w.x = pack2(v0[0], v0[1]); w.y = pack2(v0[2], v0[3]); w.z = pack2(v1[0], v1[1]); w.w = pack2(v1[2], v1[3]);
                    *(u32x4*)(rowp + bj * 128) = w; } }
    }
};
struct EpiGLU {
    static constexpr bool PERM = true, AFTER_DRAIN = false; __device__ __forceinline__ constexpr bool perm() const { return true; }
    const bf16_t* Y; bf16_t* O; const float* bias;
    __device__ __forceinline__ void operator()(const f32x4 (&acc)[2][2][4][2], const pg8::Unit& u, int wr, int wc, int fr, int fq) const {
        const int row0 = u.pm * 256 + wr * 64 + fr, col0 = u.pn * 256 + wc * 32 + 8 * fq;
#pragma unroll
        for (int ai = 0; ai < 2; ++ai)
#pragma unroll
            for (int m = 0; m < 4; ++m) { const size_t ro = (size_t)(row0 + ai * 128 + m * 16) * 512 + col0;
#pragma unroll
                for (int bj = 0; bj < 2; ++bj) { const f32x4 v0 = acc[ai][bj][m][0], v1 = acc[ai][bj][m][1];
                    const u32x4 yv = *(const u32x4*)(Y + ro + bj * 128);
                    const f32x4 b0 = *(const f32x4*)(bias + col0 + bj * 128), b1 = *(const f32x4*)(bias + col0 + bj * 128 + 4);
                    u32x4 w;
                    w.x = pack2(bflo(yv.x) * sigmoid_fast(v0[0] + b0[0]), bfhi(yv.x) * sigmoid_fast(v0[1] + b0[1]));
                    w.y = pack2(bflo(yv.y) * sigmoid_fast(v0[2] + b0[2]), bfhi(yv.y) * sigmoid_fast(v0[3] + b0[3]));
                    w.z = pack2(bflo(yv.z) * sigmoid_fast(v1[0] + b1[0]), bfhi(yv.z) * sigmoid_fast(v1[1] + b1[1]));
                    w.w = pack2(bflo(yv.w) * sigmoid_fast(v1[2] + b1[2]), bfhi(yv.w) * sigmoid_fast(v1[3] + b1[3]));
                    *(u32x4*)(O + ro + bj * 128) = w; } }
    }
};
struct EpiGen {
    static constexpr bool AFTER_DRAIN = false;
    int mode;
    void* O; const bf16_t* Y; const float* bias; float scale; int ldc;
    __device__ __forceinline__ bool perm() const { return mode != 1; }
    __device__ __forceinline__ void operator()(const f32x4 (&acc)[2][2][4][2], const pg8::Unit& u, int wr, int wc, int fr, int fq) const {
        if (mode == 0) { EpiSwiGLU e{(bf16_t*)O}; e(acc, u, wr, wc, fr, fq); }
        else if (mode == 1) { EpiResid e{(float*)O, scale, 0}; e(acc, u, wr, wc, fr, fq); }
        else if (mode == 2) { EpiBf16 e{(bf16_t*)O, ldc}; e(acc, u, wr, wc, fr, fq); }
        else { EpiGLU e{Y, (bf16_t*)O, bias}; e(acc, u, wr, wc, fr, fq); }
    }
};
__device__ __forceinline__ void run_gemm(LAS unsigned char* lds, const bf16_t* A, const bf16_t* Bt, int N, int K, const EpiGen& E) {
    pg8::Gemm g{A, Bt, MROWS, N, K, K}; pg8::StaticOrder S; S.init(MROWS, N, (int)gridDim.x, obid());
    pg8::gemm_phase2<EpiGen, pg8::StaticOrder, GEMM_ALIGN, GEMM_SP2>(lds, g, S, E);
}

template <class Epi, bool ALIGN = GEMM_ALIGN> __device__ __forceinline__ void run_gemm(LAS unsigned char* lds, const bf16_t* A, const bf16_t* Bt, int N, int K, const Epi& E) {
    pg8::Gemm g{A, Bt, MROWS, N, K, K}; pg8::StaticOrder S; S.init(MROWS, N, (int)gridDim.x, obid());
    pg8::gemm_phase2<Epi, pg8::StaticOrder, ALIGN, GEMM_SP2>(lds, g, S, E);
}
__device__ __forceinline__ void run_gemm_resid(LAS unsigned char* lds, const bf16_t* A, const bf16_t* Bt, int N, int K, float* H, float scale) {
    { pg8::Gemm g{A, Bt, MROWS, N, K, K}; pg8::HeadOrder S; S.init2(MROWS, N, (int)gridDim.x, obid()); EpiResid E{H, scale, 0};
      pg8::gemm_phase2<EpiResid, pg8::HeadOrder, ALIGN_RES, GEMM_SP2>(lds, g, S, E); }
    { pg8::Gemm g{A, Bt, MROWS, N, 256, K}; pg8::TailOrder S; S.init2(MROWS, N, (int)gridDim.x, obid(), K / 256); EpiResid E{H, scale, 1};
      pg8::gemm_phase2<EpiResid, pg8::TailOrder, GEMM_ALIGN, GEMM_SP2>(lds, g, S, E); }
}
struct CvtTile { const float* src; bf16_t* dst; int ld_src, ld_dst; };
__device__ __forceinline__ CvtTile convert_desc(const Params& p, int t) {
        bf16_t* W = (bf16_t*)(p.ws + WS_W);
        const int l = t / 5120; int r = t % 5120;
        bf16_t* Wl = W + (size_t)l * WL;
        const float* src; int ld_src; bf16_t* dst; int ld_dst;
        if (r < 1408 || (r >= 3008 && r < 4416)) {
            const bool second = r >= 3008; if (second) r -= 3008;
            const int tn = r >> 4, tk = r & 15, n0 = tn * 64, pn = n0 >> 8, bj = (n0 >> 7) & 1, i0 = n0 & 127;
            const float* g = (second ? p.in[26] : p.in[3]) + (size_t)l * DM * DFF; const float* up = (second ? p.in[27] : p.in[4]) + (size_t)l * DM * DFF;
            src = (bj ? up : g) + (size_t)(tk * 64) * DFF + pn * 128 + i0; ld_src = DFF;
            dst = Wl + (second ? WO_GU2 : WO_GU1) + (size_t)n0 * DM + tk * 64; ld_dst = DM;
        } else if (r < 2112 || r >= 4416) {
            const bool second = r >= 4416; r -= second ? 4416 : 1408;
            const int tn = r / 44, tk = r % 44;
            src = (second ? p.in[28] : p.in[5]) + (size_t)l * DFF * DM + (size_t)(tk * 64) * DM + tn * 64; ld_src = DM;
            dst = Wl + (second ? WO_D2 : WO_D1) + (size_t)(tn * 64) * DFF + tk * 64; ld_dst = DFF;
        } else if (r < 2688) {
            r -= 2112; const int tn = r >> 4, tk = r & 15, n0 = tn * 64, c0 = n0 < 1792 ? n0 : n0 + 8;
            src = p.in[7] + (size_t)l * DM * INW + (size_t)(tk * 64) * INW + c0; ld_src = INW;
            dst = Wl + WO_IN + (size_t)n0 * DM + tk * 64; ld_dst = DM;
        } else if (r < 2752) {
            r -= 2688; const int tn = r >> 3, tk = r & 7;
            src = p.in[21] + (size_t)l * 512 * 512 + (size_t)(tk * 64) * 512 + tn * 64; ld_src = 512;
            dst = Wl + WO_GLU + (size_t)(tn * 64) * 512 + tk * 64; ld_dst = 512;
        } else {
            r -= 2752; const int tn = r >> 4, tk = r & 15;
            src = p.in[24] + (size_t)l * DM * DM + (size_t)(tk * 64) * DM + tn * 64; ld_src = DM;
            dst = Wl + WO_OUT + (size_t)(tn * 64) * DM + tk * 64; ld_dst = DM;
        }
        return CvtTile{src, dst, ld_src, ld_dst};
}
__device__ __forceinline__ void convert_weights(const Params& p, LAS unsigned char* lds) {
    LAS float* T = (LAS float*)lds;
    const int tid = otid(), kr = tid >> 4, c4 = (tid & 15) * 4, n = tid >> 3, k8 = (tid & 7) * 8;
    int t = obid();
    if (t >= 2 * 5120) return;
    CvtTile cur = convert_desc(p, t);
    f32x4 v0 = *(const f32x4*)(cur.src + (size_t)kr * cur.ld_src + c4), v1 = *(const f32x4*)(cur.src + (size_t)(kr + 32) * cur.ld_src + c4);
    for (;;) {
        const int tn = t + (int)gridDim.x; const bool has = tn < 2 * 5120;
        CvtTile nxt = cur; f32x4 w0 = v0, w1 = v1;
        if (has) { nxt = convert_desc(p, tn); w0 = *(const f32x4*)(nxt.src + (size_t)kr * nxt.ld_src + c4); w1 = *(const f32x4*)(nxt.src + (size_t)(kr + 32) * nxt.ld_src + c4); }
        T[kr * 65 + c4 + 0] = v0[0]; T[kr * 65 + c4 + 1] = v0[1]; T[kr * 65 + c4 + 2] = v0[2]; T[kr * 65 + c4 + 3] = v0[3];
        T[(kr + 32) * 65 + c4 + 0] = v1[0]; T[(kr + 32) * 65 + c4 + 1] = v1[1]; T[(kr + 32) * 65 + c4 + 2] = v1[2]; T[(kr + 32) * 65 + c4 + 3] = v1[3];
        __syncthreads();
        { u32x4 w;
          w.x = pack2(T[(k8 + 0) * 65 + n], T[(k8 + 1) * 65 + n]); w.y = pack2(T[(k8 + 2) * 65 + n], T[(k8 + 3) * 65 + n]);
          w.z = pack2(T[(k8 + 4) * 65 + n], T[(k8 + 5) * 65 + n]); w.w = pack2(T[(k8 + 6) * 65 + n], T[(k8 + 7) * 65 + n]);
          *(u32x4*)(cur.dst + (size_t)n * cur.ld_dst + k8) = w; }
        __syncthreads();
        if (!has) break;
        cur = nxt; v0 = w0; v1 = w1; t = tn;
    }
}
__device__ __forceinline__ void s5_params(const Params& p) {
    const int gt = obid() * NTHR + otid();
    if (gt >= 2 * 32 * 64) return;
    const int l = gt >> 11, g = (gt >> 6) & 31, q = gt & 63;
    float* P = (float*)(p.ws + WS_S5P) + (size_t)l * S5P_L;
    const float are = p.in[13][gt], aim = p.in[14][gt], dt = expf(p.in[15][l * 32 + g]);
    const float mag = expf(are * dt), ar = mag * cosf(aim * dt), ai = mag * sinf(aim * dt);
    P[(g * 64 + q) * 2] = ar; P[(g * 64 + q) * 2 + 1] = ai;
    float pr = ar, pi = ai;
#pragma unroll
    for (int i = 0; i < 6; ++i) { const float nr = pr * pr - pi * pi, ni = 2.f * pr * pi; pr = nr; pi = ni; }
    P[4096 + (g * 64 + q) * 2] = pr; P[4096 + (g * 64 + q) * 2 + 1] = pi;
    const float nre = ar - 1.f, nim = ai, den = 1.f / (are * are + aim * aim);
    const float cr = (nre * are + nim * aim) * den, ci = (nim * are - nre * aim) * den;
    const float* bre = p.in[16] + (size_t)gt * 16; const float* bim = p.in[17] + (size_t)gt * 16;
#pragma unroll
    for (int c = 0; c < 16; ++c) { const float br = bre[c], bi = bim[c];
        P[8192 + ((g * 16 + c) * 64 + q) * 2] = cr * br - ci * bi; P[8192 + ((g * 16 + c) * 64 + q) * 2 + 1] = cr * bi + ci * br; }
}

template <int MODE> __device__ __forceinline__ void norm_rows(const Params& p, LAS unsigned char* lds, const float* gain, int layer) {
    const int tid = otid(), lane = tid & 63, wid = tid >> 6;
    float* H = (float*)(p.ws + WS_H); bf16_t* XN = (bf16_t*)(p.ws + WS_XN);
    LAS float* wba = (LAS float*)lds;
    if (MODE == 1) {
        const float* win = p.in[7] + (size_t)layer * DM * INW;
        for (int i = tid; i < 2048; i += NTHR) { const int k = i >> 1, h = i & 1; const f32x4 v = *(const f32x4*)(win + (size_t)k * INW + 1792 + 4 * h);
            wba[k * 8 + 4 * h + 0] = v[0]; wba[k * 8 + 4 * h + 1] = v[1]; wba[k * 8 + 4 * h + 2] = v[2]; wba[k * 8 + 4 * h + 3] = v[3]; }
        __syncthreads();
    }
    for (int row0 = obid() * 8 + wid; row0 < MROWS; row0 += gridDim.x * 16) {
        f32x4 vv[2][4];
#pragma unroll
        for (int k2 = 0; k2 < 2; ++k2) {
            const int row = row0 + k2 * (int)gridDim.x * 8;
            if (row < MROWS) {
                const int b = row / LP, posb = row - b * LP; (void)b; (void)posb;
                f32x4 (&v)[4] = vv[k2];
                if (MODE == 3) {
                    const float* src = nullptr;
                    if (posb >= 128) src = p.in[0] + ((size_t)b * SEQ + (posb - 128)) * DM; else if (posb >= PADF) src = p.in[1] + (size_t)(posb - PADF) * DM;
#pragma unroll
                    for (int i = 0; i < 4; ++i) { v[i] = src ? *(const f32x4*)(src + (lane + 64 * i) * 4) : (f32x4){0.f, 0.f, 0.f, 0.f}; *(f32x4*)(H + (size_t)row * DM + (lane + 64 * i) * 4) = v[i]; }
                } else {
#pragma unroll
                    for (int i = 0; i < 4; ++i) v[i] = *(const f32x4*)(H + (size_t)row * DM + (lane + 64 * i) * 4);
                }
            }
        }
#pragma unroll
        for (int k2 = 0; k2 < 2; ++k2) {
            const int row = row0 + k2 * (int)gridDim.x * 8;
            if (row < MROWS) {
                const int b = row / LP, posb = row - b * LP; (void)b; (void)posb;
                f32x4 (&v)[4] = vv[k2];
                float ss = 0.f;
#pragma unroll
                for (int i = 0; i < 4; ++i) ss += v[i][0] * v[i][0] + v[i][1] * v[i][1] + v[i][2] * v[i][2] + v[i][3] * v[i][3];
#pragma unroll
                for (int d = 1; d < 64; d <<= 1) ss += __shfl_xor(ss, d);
                const float rstd = rsqrtf(ss * (1.f / 1024.f) + 1e-6f);
                float ba[8];
#pragma unroll
                for (int e = 0; e < 8; ++e) ba[e] = 0.f;
#pragma unroll
                for (int i = 0; i < 4; ++i) {
                    const f32x4 g4 = *(const f32x4*)(gain + (lane + 64 * i) * 4);
                    const f32x4 y = v[i] * g4 * rstd;
                    if (MODE == 2) { if (posb >= 128) *(f32x4*)(p.out + ((size_t)b * SEQ + (posb - 128)) * DM + (lane + 64 * i) * 4) = y; }
                    else { u32x2 w; w.x = pack2(y[0], y[1]); w.y = pack2(y[2], y[3]); *(u32x2*)(XN + (size_t)row * DM + (lane + 64 * i) * 4) = w; }
                    if (MODE == 1) {
#pragma unroll
                        for (int j = 0; j < 4; ++j) { const int k = (lane + 64 * i) * 4 + j;
#pragma unroll
                            for (int e = 0; e < 8; ++e) ba[e] += y[j] * wba[k * 8 + e]; }
                    }
                }
                if (MODE == 1) {
#pragma unroll
                    for (int e = 0; e < 8; ++e) {
#pragma unroll
                        for (int d = 1; d < 64; d <<= 1) ba[e] += __shfl_xor(ba[e], d); }
                    if (lane == 0) { float* o = (float*)(p.ws + WS_BA) + (size_t)row * 8;
#pragma unroll
                        for (int e = 0; e < 8; ++e) o[e] = ba[e]; }
                }

            }
        }
    }
    if (MODE == 1) __syncthreads();
}

#define XB_TMO      128
#define XB_XCNT(j)  (256  + 64 * (j))
#define XB_XSUB(j)  (1280 + 64 * (j))
#define XB_XGEN(j)  (2304 + 64 * (j))
#define XB_TOP      3328
#define XB_TOPGEN   3392
#define XCD_BAR_WORDS 3456
#define XB_SPIN_CAP (1u << 18)

__device__ __forceinline__ unsigned xb_ld(unsigned* p)              { return __hip_atomic_load(p, __ATOMIC_RELAXED, __HIP_MEMORY_SCOPE_AGENT); }
__device__ __forceinline__ unsigned xb_add(unsigned* p, unsigned v) { return __hip_atomic_fetch_add(p, v, __ATOMIC_RELAXED, __HIP_MEMORY_SCOPE_AGENT); }
__device__ __forceinline__ unsigned xb_xcc_id() { return (unsigned)__builtin_amdgcn_s_getreg((3 << 11) | 20) & 0xFu; }
#define XB_SPIN(cond, bar) do { unsigned _sp = 0; while (cond) { __builtin_amdgcn_s_sleep(1); \
    if ((++_sp & 255u) == 0u) { if (xb_ld(&(bar)[XB_TMO])) break; if (_sp > XB_SPIN_CAP) { atomicAdd(&(bar)[XB_TMO], 1u); break; } } } } while (0)

struct XcdBarrier {
    unsigned* bar; unsigned x;
    volatile LAS unsigned* st;
};

__device__ __forceinline__ XcdBarrier xcd_barrier_post(unsigned* bar, volatile LAS unsigned* st) {
    XcdBarrier b; b.bar = bar; b.x = xb_xcc_id(); b.st = st;
    if (otid() == 0) (void)xb_add(&bar[XB_XCNT(b.x)], 1u);
    return b;
}
__device__ __forceinline__ void xcd_barrier_complete(unsigned* bar, unsigned x, unsigned& nloc, unsigned& nx) {
    const unsigned G = gridDim.x * gridDim.y * gridDim.z;
    unsigned sum, cnt, mine, sp = 0u;
    for (;;) {
        sum = 0u; cnt = 0u; mine = 0u;
#pragma unroll
        for (unsigned j = 0; j < 16; ++j) { const unsigned c = xb_ld(&bar[XB_XCNT(j)]); sum += c; cnt += (c > 0u) ? 1u : 0u; mine = (j == x) ? c : mine; }
        if (sum == G) break;
        __builtin_amdgcn_s_sleep(1);
        if ((++sp & 255u) == 0u) { if (xb_ld(&bar[XB_TMO])) break; if (sp > XB_SPIN_CAP) { atomicAdd(&bar[XB_TMO], 1u); break; } }
    }
    nloc = mine > 0u ? mine : 1u; nx = cnt > 0u ? cnt : 1u;
}

__device__ __forceinline__ void xcd_barrier(const XcdBarrier& b) {
    asm volatile("s_waitcnt vmcnt(0)" ::: "memory");
    __syncthreads();
    if (otid() == 0) {
        unsigned* bar = b.bar;
        __builtin_amdgcn_s_waitcnt(0);
        unsigned nloc = b.st[0], nx = b.st[1];
        if (nloc == 0u) { xcd_barrier_complete(bar, b.x, nloc, nx); b.st[0] = nloc; b.st[1] = nx; }
        const unsigned old = xb_add(&bar[XB_XSUB(b.x)], 1u);
        const unsigned gen = old / nloc;
        if (old + 1u == (gen + 1u) * nloc) {
            __builtin_amdgcn_fence(__ATOMIC_RELEASE, "agent");
            asm volatile("s_waitcnt vmcnt(0)" ::: "memory");
            const unsigned og = xb_add(&bar[XB_TOP], 1u);
            const unsigned tg = og / nx;
            if (og + 1u == (tg + 1u) * nx) xb_add(&bar[XB_TOPGEN], 1u);
            else XB_SPIN(xb_ld(&bar[XB_TOPGEN]) == tg, bar);
            __builtin_amdgcn_fence(__ATOMIC_ACQUIRE, "agent");
            xb_add(&bar[XB_XGEN(b.x)], 1u);
            asm volatile("s_waitcnt vmcnt(0)" ::: "memory");
        } else {
            XB_SPIN(xb_ld(&bar[XB_XGEN(b.x)]) == gen, bar);
            __builtin_amdgcn_fence(__ATOMIC_ACQUIRE, "agent");
            asm volatile("s_waitcnt vmcnt(0)" ::: "memory");
        }
    }
    __syncthreads();
}


template <int N> __device__ __forceinline__ float row_shl(float v) { return __int_as_float(__builtin_amdgcn_update_dpp(0, __float_as_int(v), 0x100 + N, 0xf, 0xf, true)); }
__device__ __forceinline__ void sb_item(LAS unsigned char* lds, int item, const bf16_t* proj, bf16_t* mixed, const float* gain) {
    const int tid = otid(), lane = tid & 63, wid = tid >> 6, fr = lane & 15, fq = lane >> 4;
    const int qb = item % NQB, bh = item / NQB, b = bh >> 2, hd = bh & 3;
    LAS bf16_t* Qs = (LAS bf16_t*)lds;
    LAS bf16_t* Ks = Qs + 128 * 72;
    LAS bf16_t* Vt = Ks + 128 * 72;
    LAS bf16_t* Ps = Vt + 64 * 136 + wid * (16 * 136);
    const size_t rowbase = (size_t)b * LP;
    { const int r = tid >> 2, seg = tid & 3;
      const bf16_t* src = proj + (rowbase + (size_t)qb * 128 + r) * PW + hd * 64 + seg * 16;
      const u32x4 v0 = *(const u32x4*)src, v1 = *(const u32x4*)(src + 8);
      *(LAS u32x4*)(Qs + r * 72 + seg * 16) = v0; *(LAS u32x4*)(Qs + r * 72 + seg * 16 + 8) = v1; }
    f32x4 o[4];
#pragma unroll
    for (int i = 0; i < 4; ++i) o[i] = (f32x4){0.f, 0.f, 0.f, 0.f};
    float carry[4] = {0.f, 0.f, 0.f, 0.f};
    bf16x8 qa[2];
    u32x4 k0, k1, v0, v1;
    { const int r = tid >> 2, seg = tid & 3;
      const bf16_t* srck = proj + (rowbase + (size_t)qb * 128 + r) * PW + 256 + hd * 64 + seg * 16;
      k0 = *(const u32x4*)srck; k1 = *(const u32x4*)(srck + 8); v0 = *(const u32x4*)(srck + 256); v1 = *(const u32x4*)(srck + 264); }
    for (int kb = qb; kb >= 0; --kb) {
        { const int r = tid >> 2, seg = tid & 3;
          *(LAS u32x4*)(Ks + r * 72 + seg * 16) = k0; *(LAS u32x4*)(Ks + r * 72 + seg * 16 + 8) = k1;
          LAS bf16_t* vt = Vt + (seg * 16) * 136 + r;
          vt[0 * 136] = (bf16_t)(v0.x & 0xffff); vt[1 * 136] = (bf16_t)(v0.x >> 16); vt[2 * 136] = (bf16_t)(v0.y & 0xffff); vt[3 * 136] = (bf16_t)(v0.y >> 16);
          vt[4 * 136] = (bf16_t)(v0.z & 0xffff); vt[5 * 136] = (bf16_t)(v0.z >> 16); vt[6 * 136] = (bf16_t)(v0.w & 0xffff); vt[7 * 136] = (bf16_t)(v0.w >> 16);
          vt[8 * 136] = (bf16_t)(v1.x & 0xffff); vt[9 * 136] = (bf16_t)(v1.x >> 16); vt[10 * 136] = (bf16_t)(v1.y & 0xffff); vt[11 * 136] = (bf16_t)(v1.y >> 16);
          vt[12 * 136] = (bf16_t)(v1.z & 0xffff); vt[13 * 136] = (bf16_t)(v1.z >> 16); vt[14 * 136] = (bf16_t)(v1.w & 0xffff); vt[15 * 136] = (bf16_t)(v1.w >> 16); }
        __syncthreads();
        if (kb > 0) { const int r = tid >> 2, seg = tid & 3;
            const bf16_t* srck = proj + (rowbase + (size_t)(kb - 1) * 128 + r) * PW + 256 + hd * 64 + seg * 16;
            k0 = *(const u32x4*)srck; k1 = *(const u32x4*)(srck + 8); v0 = *(const u32x4*)(srck + 256); v1 = *(const u32x4*)(srck + 264); }
        if (kb == qb) {
#pragma unroll
            for (int ks = 0; ks < 2; ++ks) qa[ks] = *(const LAS bf16x8*)(Qs + (wid * 16 + fr) * 72 + ks * 32 + fq * 8);
        }
        f32x4 z[8];
#pragma unroll
        for (int f = 0; f < 8; ++f) { z[f] = (f32x4){0.f, 0.f, 0.f, 0.f};
#pragma unroll
            for (int ks = 0; ks < 2; ++ks) { const bf16x8 kf = *(const LAS bf16x8*)(Ks + (f * 16 + fr) * 72 + ks * 32 + fq * 8); z[f] = mfma16(qa[ks], kf, z[f]); } }
        const int qpos0 = qb * 128 + wid * 16 + fq * 4;
        float lk[8][4];
#pragma unroll
        for (int f = 0; f < 8; ++f) { const int kpos = kb * 128 + f * 16 + fr;
#pragma unroll
            for (int r = 0; r < 4; ++r) { const bool valid = (kpos < qpos0 + r) & (kpos >= PADF);
                const float zs = z[f][r] * 0.125f; z[f][r] = zs; const float sp = softplus_fast(zs); float v = valid ? -sp : 0.f;
                v += row_shl<1>(v); v += row_shl<2>(v); v += row_shl<4>(v); v += row_shl<8>(v);
                lk[f][r] = v; } }
#pragma unroll
        for (int r = 0; r < 4; ++r) { float run = carry[r];
#pragma unroll
            for (int f = 7; f >= 0; --f) { const int kpos = kb * 128 + f * 16 + fr; const bool valid = (kpos < qpos0 + r) & (kpos >= PADF);
                const float tot = __shfl(lk[f][r], 0, 16);
                const float ew = __expf(fminf(z[f][r] + lk[f][r] + run, 0.f));
                const float w = valid ? ew : 0.f;
                run += tot;
                Ps[(fq * 4 + r) * 136 + f * 16 + fr] = f2bf(w); }
            carry[r] = run; }
        WAVE_LDS_SYNC();
#pragma unroll
        for (int ks = 0; ks < 4; ++ks) { const bf16x8 pa = *(const LAS bf16x8*)(Ps + fr * 136 + ks * 32 + fq * 8);
#pragma unroll
            for (int df = 0; df < 4; ++df) { const bf16x8 vb = *(const LAS bf16x8*)(Vt + (df * 16 + fr) * 136 + ks * 32 + fq * 8); o[df] = mfma16(pa, vb, o[df]); } }
        const bool wdone = (carry[0] < -60.f) && (carry[1] < -60.f) && (carry[2] < -60.f) && (carry[3] < -60.f);
        const int cont = __syncthreads_or(wdone ? 0 : 1);
        if (!cont) break;
    }
#pragma unroll
    for (int r = 0; r < 4; ++r) { float ss = 0.f;
#pragma unroll
        for (int df = 0; df < 4; ++df) ss += o[df][r] * o[df][r];
#pragma unroll
        for (int d = 1; d < 16; d <<= 1) ss += __shfl_xor(ss, d, 16);
        const float rstd = rsqrtf(ss * (1.f / 64.f) + 1e-6f);
        bf16_t* dst = mixed + (rowbase + (size_t)qb * 128 + wid * 16 + fq * 4 + r) * DM + hd * 64;
#pragma unroll
        for (int df = 0; df < 4; ++df) dst[df * 16 + fr] = f2bf(o[df][r] * rstd * gain[df * 16 + fr]); }
}

struct DNBufs { bf16_t* W; bf16_t* QG; bf16_t* ATT; bf16_t* KT; bf16_t* UT; float* EGL; float* ODN; };
__device__ __forceinline__ DNBufs dn_bufs(const Params& p) {
    unsigned char* o = (unsigned char*)p.out;
    return DNBufs{(bf16_t*)(o + DO_W), (bf16_t*)(o + DO_QG), (bf16_t*)(o + DO_ATT), (bf16_t*)(o + DO_KT), (bf16_t*)(o + DO_UT), (float*)(o + DO_EGL), (float*)(o + DO_ODN)};
}
__device__ __forceinline__ void dn_local_item(const Params& p, LAS unsigned char* lds, int item, int layer, const bf16_t* proj, const DNBufs& D) {
    const int tid = otid(), lane = tid & 63, wid = tid >> 6, fr = lane & 15, fq = lane >> 4;
    const int n = item % NCH, bh = item / NCH, b = bh >> 2, hd = bh & 3;
    LAS float* Qf = (LAS float*)lds;
    LAS float* Kf = Qf + 64 * 65;
    LAS float* Vf = Kf + 64 * 65;
    LAS float* Lm = Vf + 64 * 65;
    LAS float* gcs = Lm + 64 * 68;
    LAS float* bts = gcs + 64;
    LAS float* scw = bts + 64;
    LAS bf16_t* Qb = (LAS bf16_t*)(scw + 64);
    LAS bf16_t* Kb = Qb + 64 * 72;
    LAS bf16_t* KTs = Kb + 64 * 72;
    LAS bf16_t* ATs = KTs + 64 * 72;
    LAS bf16_t* WTs = ATs + 64 * 72;
    LAS bf16_t* UTs = WTs + 64 * 72;
    const float* cw = p.in[9] + (size_t)layer * 4 * 768;
    const size_t pos0 = (size_t)b * LP + (size_t)n * 64;
    if (tid < 384) {
        const int cc = tid % 192, rg = tid / 192, which = cc >> 6, d = cc & 63, ch = which * 256 + hd * 64 + d;
        LAS float* dst = (which == 0 ? Qf : (which == 1 ? Kf : Vf)) + d;
        const float w0 = cw[ch], w1 = cw[768 + ch], w2 = cw[2 * 768 + ch], w3 = cw[3 * 768 + ch];
        const int r0 = rg * 32;
        if (n * 64 + r0 + 31 < PADF) {
#pragma unroll
            for (int i = 0; i < 32; ++i) dst[(r0 + i) * 65] = 0.f;
        } else {
            const bf16_t* src = proj + (pos0 + r0) * PW + 768 + ch;
            bf16_t xv[35];
#pragma unroll
            for (int i = 0; i < 35; ++i) xv[i] = src[((long)i - 3) * PW];
#pragma unroll
            for (int i = 0; i < 32; ++i) {
                const float a = w0 * bf2f(xv[i]) + w1 * bf2f(xv[i + 1]) + w2 * bf2f(xv[i + 2]) + w3 * bf2f(xv[i + 3]);
                dst[(r0 + i) * 65] = silu_fast(a) * ((n * 64 + r0 + i >= PADF) ? 1.f : 0.f);
            }
        }
    }
    if (tid < 64) {
        const int posb = n * 64 + tid; float g = 0.f, bt = 0.f;
        if (posb >= PADF) { const float* bar = (const float*)(p.ws + WS_BA) + (pos0 + tid) * 8;
            bt = 1.f / (1.f + __expf(-bar[hd]));
            const float x = bar[4 + hd] + p.in[11][layer * 4 + hd];
            g = -__expf(p.in[10][layer * 4 + hd]) * softplus_fast(x); }
        float c = g;
#pragma unroll
        for (int d = 1; d < 64; d <<= 1) { const float t = __shfl_up(c, d); if (lane >= d) c += t; }
        gcs[tid] = c; bts[tid] = bt; scw[tid] = bt * __expf(c);
    }
    __syncthreads();
    {
        const int row = tid >> 2, part = tid & 3, r = row & 63;
        LAS float* X = ((row >> 6) ? Kf : Qf) + r * 65 + part * 16; LAS bf16_t* Xb = ((row >> 6) ? Kb : Qb) + r * 72 + part * 16;
        float xv[16]; float ss = 0.f;
#pragma unroll
        for (int j = 0; j < 16; ++j) { xv[j] = X[j]; ss += xv[j] * xv[j]; }
        ss += __shfl_xor(ss, 1); ss += __shfl_xor(ss, 2);
        const float rs = rsqrtf(ss + 1e-6f);
#pragma unroll
        for (int j = 0; j < 16; j += 2) { const float a0 = xv[j] * rs, a1 = xv[j + 1] * rs; X[j] = a0; X[j + 1] = a1; *(LAS unsigned*)(Xb + j) = pack2(a0, a1); }
    }
    __syncthreads();
    const size_t ob = (size_t)item * 4096;
    const float glast = gcs[63];
#pragma unroll
    for (int idx = tid; idx < 4096; idx += NTHR) {
        const int hi = idx >> 6, lo = idx & 63;
        KTs[hi * 72 + lo] = f2bf(Kf[lo * 65 + hi] * __expf(glast - gcs[lo]));
    }
    if (tid == 0) D.EGL[item] = __expf(glast);
#pragma unroll
    for (int q4 = 0; q4 < 4; ++q4) {
        const int fid = wid * 4 + q4, gram = fid >> 4, fi = (fid >> 2) & 3, fj = fid & 3;
        LAS bf16_t* X = gram ? Qb : Kb;
        f32x4 acc = (f32x4){0.f, 0.f, 0.f, 0.f};
#pragma unroll
        for (int ks = 0; ks < 2; ++ks) { const bf16x8 a = *(const LAS bf16x8*)(X + (fi * 16 + fr) * 72 + ks * 32 + fq * 8);
            const bf16x8 bb = *(const LAS bf16x8*)(Kb + (fj * 16 + fr) * 72 + ks * 32 + fq * 8); acc = mfma16(a, bb, acc); }
        const int j = fj * 16 + fr; const float gj = gcs[j];
#pragma unroll
        for (int r = 0; r < 4; ++r) { const int i = fi * 16 + fq * 4 + r;
            const float de_ = __expf(fminf(gcs[i] - gj, 0.f)); const float dec = (i >= j) ? de_ : 0.f;
            if (gram == 0) Lm[i * 68 + j] = (i > j) ? bts[i] * acc[r] * dec : 0.f;
            else ATs[i * 72 + j] = f2bf(acc[r] * 0.125f * dec); }
    }
    __syncthreads();
    if (tid < 128) {
        const int col = tid & 63; const bool isw = tid >= 64;
        LAS float* X = (isw ? Kf : Vf) + col;
        const LAS float* sc = isw ? scw : bts;
        float x[64];
#pragma unroll
        for (int I = 0; I < 4; ++I) {
            float r[16];
#pragma unroll
            for (int ii = 0; ii < 16; ++ii) { const int i = I * 16 + ii; r[ii] = X[i * 65] * sc[i]; }
            asm volatile("" ::: "memory");
#pragma unroll
            for (int J = 0; J < I; ++J) {
#pragma unroll
                for (int ii = 0; ii < 16; ++ii) { const int i = I * 16 + ii;
#pragma unroll
                    for (int j4 = 0; j4 < 4; ++j4) { const f32x4 l4 = *(const LAS f32x4*)(Lm + i * 68 + J * 16 + j4 * 4);
                        r[ii] -= l4[0] * x[J * 16 + j4 * 4] + l4[1] * x[J * 16 + j4 * 4 + 1] + l4[2] * x[J * 16 + j4 * 4 + 2] + l4[3] * x[J * 16 + j4 * 4 + 3]; }
                    if ((ii & 3) == 3) asm volatile("" ::: "memory");
                }
            }
#pragma unroll
            for (int ii = 0; ii < 16; ++ii) { const int i = I * 16 + ii; float sacc = r[ii];
#pragma unroll
                for (int jj = 0; jj < ii; ++jj) sacc -= Lm[i * 68 + I * 16 + jj] * x[I * 16 + jj];
                x[i] = sacc; X[i * 65] = sacc;
                if ((ii & 3) == 3) asm volatile("" ::: "memory");
            }
        }
    }
    __syncthreads();
#pragma unroll
    for (int idx = tid; idx < 4096; idx += NTHR) {
        const int hi = idx >> 6, lo = idx & 63;
        WTs[hi * 72 + lo] = f2bf(Kf[lo * 65 + hi]);
        UTs[hi * 72 + lo] = f2bf(Vf[lo * 65 + hi]);
    }
    __syncthreads();
    {   const int mt = wid >> 1, half = wid & 1;
        const LAS bf16_t* Xs = (mt == 0 || mt == 2) ? KTs : ATs;
        const LAS bf16_t* Ys = mt < 2 ? WTs : UTs;
        bf16_t* dstp = mt == 0 ? D.W : (mt == 1 ? D.QG : (mt == 2 ? D.ATT : D.KT));
#pragma unroll
        for (int q8 = 0; q8 < 8; ++q8) {
            const int fi = half * 2 + (q8 >> 2), fj = q8 & 3;
            f32x4 acc = (f32x4){0.f, 0.f, 0.f, 0.f};
#pragma unroll
            for (int ks = 0; ks < 2; ++ks) acc = mfma16(*(const LAS bf16x8*)(Xs + (fi * 16 + fr) * 72 + ks * 32 + fq * 8), *(const LAS bf16x8*)(Ys + (fj * 16 + fr) * 72 + ks * 32 + fq * 8), acc);
            if (mt == 0) {
#pragma unroll
                for (int r = 0; r < 4; ++r) dstp[ob + (fi * 16 + fq * 4 + r) * 64 + fj * 16 + fr] = f2bf(-acc[r]);
            } else if (mt == 1) {
#pragma unroll
                for (int r = 0; r < 4; ++r) { const int c = fi * 16 + fq * 4 + r; dstp[ob + c * 64 + fj * 16 + fr] = f2bf(Qf[c * 65 + fj * 16 + fr] * 0.125f * __expf(gcs[c]) - acc[r]); }
            } else {
                u32x2 w; w.x = pack2(acc[0], acc[1]); w.y = pack2(acc[2], acc[3]);
                *(u32x2*)(dstp + ob + (fj * 64 + lane) * 16 + fi * 4) = w;
            }
        }
    }
    __syncthreads();
}

__device__ __forceinline__ void dn_seq_compute(const LAS bf16_t* MYs, f32x4 (&ST)[4], float egl_cur, float* odst, int dvb, int lane, int fr, int fq) {
    constexpr int MATE = 64 * 72;
    const LAS bf16_t* CYs = MYs + MATE; const LAS bf16_t* BNs = MYs + 2 * MATE; const LAS bf16_t* DNs = BNs + 4096;
    bf16x8 amy[4][2], acy[4][2];
#pragma unroll
    for (int f = 0; f < 4; ++f)
#pragma unroll
        for (int ks = 0; ks < 2; ++ks) { const int o_ = (f * 16 + fr) * 72 + ks * 32 + fq * 4;
            const u32x2 m0 = *(const LAS u32x2*)(MYs + o_), m1 = *(const LAS u32x2*)(MYs + o_ + 16), c0 = *(const LAS u32x2*)(CYs + o_), c1 = *(const LAS u32x2*)(CYs + o_ + 16);
            const u32x4 mm = {m0.x, m0.y, m1.x, m1.y}, cc = {c0.x, c0.y, c1.x, c1.y};
            amy[f][ks] = __builtin_bit_cast(bf16x8, mm); acy[f][ks] = __builtin_bit_cast(bf16x8, cc); }
    const u32x4 b0 = *(const LAS u32x4*)(BNs + (dvb * 64 + lane) * 16), b1 = *(const LAS u32x4*)(BNs + (dvb * 64 + lane) * 16 + 8);
    const u32x4 d0 = *(const LAS u32x4*)(DNs + (dvb * 64 + lane) * 16), d1 = *(const LAS u32x4*)(DNs + (dvb * 64 + lane) * 16 + 8);
    bf16x8 bop[2];
#pragma unroll
    for (int ks = 0; ks < 2; ++ks) { const u32x4 w = {pack2(ST[2 * ks][0], ST[2 * ks][1]), pack2(ST[2 * ks][2], ST[2 * ks][3]), pack2(ST[2 * ks + 1][0], ST[2 * ks + 1][1]), pack2(ST[2 * ks + 1][2], ST[2 * ks + 1][3])};
        bop[ks] = __builtin_bit_cast(bf16x8, w); }
    f32x4 o[4];
    o[0] = (f32x4){bflo(d0.x), bfhi(d0.x), bflo(d0.y), bfhi(d0.y)}; o[1] = (f32x4){bflo(d0.z), bfhi(d0.z), bflo(d0.w), bfhi(d0.w)};
    o[2] = (f32x4){bflo(d1.x), bfhi(d1.x), bflo(d1.y), bfhi(d1.y)}; o[3] = (f32x4){bflo(d1.z), bfhi(d1.z), bflo(d1.w), bfhi(d1.w)};
    ST[0] = ST[0] * egl_cur + (f32x4){bflo(b0.x), bfhi(b0.x), bflo(b0.y), bfhi(b0.y)}; ST[1] = ST[1] * egl_cur + (f32x4){bflo(b0.z), bfhi(b0.z), bflo(b0.w), bfhi(b0.w)};
    ST[2] = ST[2] * egl_cur + (f32x4){bflo(b1.x), bfhi(b1.x), bflo(b1.y), bfhi(b1.y)}; ST[3] = ST[3] * egl_cur + (f32x4){bflo(b1.z), bfhi(b1.z), bflo(b1.w), bfhi(b1.w)};
#pragma unroll
    for (int f = 0; f < 4; ++f)
#pragma unroll
        for (int ks = 0; ks < 2; ++ks) { o[f] = mfma16(acy[f][ks], bop[ks], o[f]); ST[f] = mfma16(amy[f][ks], bop[ks], ST[f]); }
#pragma unroll
    for (int cf = 0; cf < 4; ++cf)
#pragma unroll
        for (int r = 0; r < 4; ++r) odst[(size_t)(cf * 16 + fq * 4 + r) * 256 + fr] = o[cf][r];
}
struct DNStage { u32x4 r0, r1, r2, r3; };
__device__ __forceinline__ void dn_seq_block(LAS unsigned char* lds, int bh, const DNBufs& D) {
    const int tid = otid(), lane = tid & 63, wid = tid >> 6, fr = lane & 15, fq = lane >> 4;
    const int b = bh >> 2, hd = bh & 3, dvb = wid;
    constexpr int MATE = 64 * 72;
    constexpr int BUFE = 2 * MATE + 2 * 4096;
    LAS bf16_t* L0 = (LAS bf16_t*)lds;
    LAS bf16_t* STb = L0 + 2 * BUFE + wid * (16 * 72);
    LAS float* egls = (LAS float*)(L0 + 2 * BUFE + 8 * (16 * 72));
    const int goff = tid * 8, loff = (tid >> 3) * 72 + (tid & 7) * 8;
#define DN_GLOAD(S, nq) do { const int nq_ = (nq) < NCH ? (nq) : NCH - 1; const size_t ob_ = (size_t)(bh * NCH + nq_) * 4096 + goff; S.r0 = *(const u32x4*)(D.W + ob_); S.r1 = *(const u32x4*)(D.QG + ob_); \
        S.r2 = *(const u32x4*)(D.ATT + ob_); S.r3 = *(const u32x4*)(D.KT + ob_); } while (0)
#define DN_LSTORE(S, bq) do { LAS bf16_t* B_ = L0 + (bq) * BUFE; *(LAS u32x4*)(B_ + loff) = S.r0; *(LAS u32x4*)(B_ + MATE + loff) = S.r1; *(LAS u32x4*)(B_ + 2 * MATE + goff) = S.r2; \
        *(LAS u32x4*)(B_ + 2 * MATE + 4096 + goff) = S.r3; } while (0)
    DNStage s0, s1, s2;
    if (tid < NCH) egls[tid] = D.EGL[bh * NCH + tid];
    DN_GLOAD(s0, 0); DN_LSTORE(s0, 0);
    DN_GLOAD(s0, 1); DN_GLOAD(s1, 2); DN_GLOAD(s2, 3);
    __syncthreads();
    f32x4 ST[4];
#pragma unroll
    for (int f = 0; f < 4; ++f) ST[f] = (f32x4){0.f, 0.f, 0.f, 0.f};
#define DN_STEP(n, S) do { \
        DN_LSTORE(S, ((n) + 1) & 1); DN_GLOAD(S, (n) + 4); \
        if (wid < 4) dn_seq_compute(L0 + ((n) & 1) * BUFE, ST, egls[n], D.ODN + ((size_t)b * LP + (size_t)(n) * 64) * 256 + hd * 64 + dvb * 16, dvb, lane, fr, fq); \
        asm volatile("s_waitcnt lgkmcnt(0)" ::: "memory"); __builtin_amdgcn_s_barrier(); asm volatile("" ::: "memory"); } while (0)
    for (int n = 0; n < NCH; n += 3) { DN_STEP(n, s0); DN_STEP(n + 1, s1); DN_STEP(n + 2, s2); }
#undef DN_STEP
#undef DN_GLOAD
#undef DN_LSTORE
}

struct S5Coef { float ar, ai; bf16x8 are[4], aim[4]; bf16x8 cmb[4]; float dd; };
template <bool FINAL> __device__ __forceinline__ void s5_load_coef(const Params& p, int layer, int g, S5Coef& K) {
    const int lane = otid() & 63, fr = lane & 15, fq = lane >> 4;
    const float* P = (const float*)(p.ws + WS_S5P) + (size_t)layer * S5P_L;
    K.ar = P[(g * 64 + lane) * 2]; K.ai = P[(g * 64 + lane) * 2 + 1];
#pragma unroll
    for (int pf = 0; pf < 4; ++pf) { bf16x8 tr, ti;
#pragma unroll
        for (int j = 0; j < 8; ++j) { const int c = (fq & 1) * 8 + j; const float* q = P + 8192 + ((g * 16 + c) * 64 + pf * 16 + fr) * 2;
            tr[j] = (short)f2bf(fq < 2 ? q[0] : 0.f); ti[j] = (short)f2bf(fq < 2 ? q[1] : 0.f); }
        K.are[pf] = tr; K.aim[pf] = ti; }
    K.dd = 0.f;
    if (FINAL) {
        const float* cre = p.in[18] + ((size_t)(layer * 32 + g) * 16 + fr) * 64; const float* cim = p.in[19] + ((size_t)(layer * 32 + g) * 16 + fr) * 64;
#pragma unroll
        for (int kk = 0; kk < 4; ++kk) { bf16x8 t;
#pragma unroll
            for (int j = 0; j < 8; ++j) { const int k = (kk & 1) * 32 + fq * 8 + j; t[j] = (short)f2bf(kk < 2 ? cre[k] : -cim[k]); }
            K.cmb[kk] = t; }
        K.dd = p.in[20][layer * 512 + g * 16 + fr];
    }
}
constexpr int S5_LDSW = 13056;
template <bool FINAL> __device__ __forceinline__ void s5_item(const Params& p, LAS unsigned char* ldsw, int item, int layer, const bf16_t* proj, const S5Coef& K) {
    const int lane = otid() & 63, fr = lane & 15, fq = lane >> 4;
    const int g = item & 31, bn = item >> 5, n = bn % NCH, b = bn / NCH;
    LAS bf16_t* Ub = (LAS bf16_t*)ldsw;
    LAS bf16_t* BUr = Ub + 64 * 32;
    LAS bf16_t* BUi = BUr + 16 * 72;
    LAS bf16_t* Sb = BUi + 16 * 72;
    const size_t pos0 = (size_t)b * LP + (size_t)n * 64;
    { const bf16_t* src = proj + (pos0 + lane) * PW + 1792 + g * 16;
      const u32x4 v0 = *(const u32x4*)src, v1 = *(const u32x4*)(src + 8); const u32x4 zz = {0u, 0u, 0u, 0u};
      *(LAS u32x4*)(Ub + lane * 32) = v0; *(LAS u32x4*)(Ub + lane * 32 + 8) = v1; *(LAS u32x4*)(Ub + lane * 32 + 16) = zz; *(LAS u32x4*)(Ub + lane * 32 + 24) = zz; }
    float* E = (float*)(p.ws + WS_E);
    float sr = 0.f, si = 0.f;
    if (FINAL) { const float* c = (const float*)(p.ws + WS_CIN) + ((size_t)((b * NCH + n) * 32 + g) * 64 + lane) * 2; sr = c[0]; si = c[1]; }
    WAVE_LDS_SYNC();
    bf16_t* YG = (bf16_t*)(p.ws + WS_XN);
    for (int tf = 0; tf < 4; ++tf) {
        const bf16x8 uf = *(const LAS bf16x8*)(Ub + (tf * 16 + fr) * 32 + fq * 8);
#pragma unroll
        for (int pf = 0; pf < 4; ++pf) {
            const f32x4 z4 = {0.f, 0.f, 0.f, 0.f};
            const f32x4 cr = mfma16(K.are[pf], uf, z4), ci = mfma16(K.aim[pf], uf, z4);
            u32x2 wr_, wi_; wr_.x = pack2(cr[0], cr[1]); wr_.y = pack2(cr[2], cr[3]); wi_.x = pack2(ci[0], ci[1]); wi_.y = pack2(ci[2], ci[3]);
            *(LAS u32x2*)(BUr + fr * 72 + pf * 16 + fq * 4) = wr_; *(LAS u32x2*)(BUi + fr * 72 + pf * 16 + fq * 4) = wi_;
        }
        WAVE_LDS_SYNC();
#pragma unroll
        for (int tl = 0; tl < 16; ++tl) {
            const float br = bf2f(BUr[tl * 72 + lane]), bi = bf2f(BUi[tl * 72 + lane]);
            const float nr = K.ar * sr - K.ai * si + br, ni = K.ar * si + K.ai * sr + bi; sr = nr; si = ni;
            if (FINAL) { Sb[tl * 136 + lane] = f2bf(sr); Sb[tl * 136 + 64 + lane] = f2bf(si); }
        }
        if (FINAL) {
            WAVE_LDS_SYNC();
            f32x4 y = (f32x4){0.f, 0.f, 0.f, 0.f};
#pragma unroll
            for (int kk = 0; kk < 4; ++kk) { const bf16x8 sa = *(const LAS bf16x8*)(Sb + fr * 136 + kk * 32 + fq * 8); y = mfma16(sa, K.cmb[kk], y); }
#pragma unroll
            for (int r = 0; r < 4; ++r) { const int tl = tf * 16 + fq * 4 + r;
                const float yv = y[r] + K.dd * bf2f(Ub[tl * 32 + fr]);
                const float x = 0.7978845608f * (yv + 0.044715f * yv * yv * yv);
                const float th = 1.f - 2.f * __builtin_amdgcn_rcpf(1.f + __expf(2.f * x));
                YG[(pos0 + tl) * 512 + g * 16 + fr] = f2bf(0.5f * yv * (1.f + th)); }
        }
        WAVE_LDS_SYNC();
    }
    if (!FINAL) { float* e = E + ((size_t)((b * NCH + n) * 32 + g) * 64 + lane) * 2; e[0] = sr; e[1] = si; }
}

__device__ __forceinline__ void s5_carry_scan(const Params& p, int layer) {
    const int tid = otid(), lane = tid & 63, gw = obid() * 8 + (tid >> 6);
    if (gw >= 64) return;
    const int b = gw >> 5, g = gw & 31;
    const float* P = (const float*)(p.ws + WS_S5P) + (size_t)layer * S5P_L;
    const float a64r = P[4096 + (g * 64 + lane) * 2], a64i = P[4096 + (g * 64 + lane) * 2 + 1];
    const float* E = (const float*)(p.ws + WS_E); float* C = (float*)(p.ws + WS_CIN);
    float cr = 0.f, ci = 0.f;
    static_assert(NCH % 43 == 0, "chunk groups");
    for (int n0 = 0; n0 < NCH; n0 += 43) {
        float er[43], ei[43];
#pragma unroll
        for (int k = 0; k < 43; ++k) { const float* e = E + ((size_t)((b * NCH + n0 + k) * 32 + g) * 64 + lane) * 2; er[k] = e[0]; ei[k] = e[1]; }
#pragma unroll
        for (int k = 0; k < 43; ++k) { float* c = C + ((size_t)((b * NCH + n0 + k) * 32 + g) * 64 + lane) * 2; c[0] = cr; c[1] = ci;
            const float nr = a64r * cr - a64i * ci + er[k], ni = a64r * ci + a64i * cr + ei[k]; cr = nr; ci = ni; }
    }
}

__device__ __forceinline__ void mix_finalize(const Params& p, int layer, const bf16_t* proj, bf16_t* mixed) {
    const int lane = otid() & 63, wid = otid() >> 6;
    const float* odn = (const float*)((unsigned char*)p.out + DO_ODN);
    const bf16_t* GL = (const bf16_t*)(p.ws + WS_XN) + (size_t)MROWS * 512;
    const float* gdn = p.in[12] + layer * 64; const float* gs5 = p.in[23] + layer * 512;
    for (int row = obid() * 8 + wid; row < MROWS; row += gridDim.x * 8) {
        { const f32x4 v = *(const f32x4*)(odn + (size_t)row * 256 + lane * 4);
          float ss = v[0] * v[0] + v[1] * v[1] + v[2] * v[2] + v[3] * v[3];
#pragma unroll
          for (int d = 1; d < 16; d <<= 1) ss += __shfl_xor(ss, d, 16);
          const float rstd = rsqrtf(ss * (1.f / 64.f) + 1e-6f);
          const u32x2 zz = *(const u32x2*)(proj + (size_t)row * PW + 1536 + lane * 4);
          const f32x4 gg = *(const f32x4*)(gdn + (lane & 15) * 4);
          u32x2 w; w.x = pack2(v[0] * rstd * gg[0] * silu_fast(bflo(zz.x)), v[1] * rstd * gg[1] * silu_fast(bfhi(zz.x)));
          w.y = pack2(v[2] * rstd * gg[2] * silu_fast(bflo(zz.y)), v[3] * rstd * gg[3] * silu_fast(bfhi(zz.y)));
          *(u32x2*)(mixed + (size_t)row * DM + 256 + lane * 4) = w; }
        { const u32x4 gv = *(const u32x4*)(GL + (size_t)row * 512 + lane * 8);
          float v[8] = {bflo(gv.x), bfhi(gv.x), bflo(gv.y), bfhi(gv.y), bflo(gv.z), bfhi(gv.z), bflo(gv.w), bfhi(gv.w)};
          float ss = 0.f;
#pragma unroll
          for (int j = 0; j < 8; ++j) ss += v[j] * v[j];
#pragma unroll
          for (int d = 1; d < 64; d <<= 1) ss += __shfl_xor(ss, d);
          const float rstd = rsqrtf(ss * (1.f / 512.f) + 1e-6f);
          const f32x4 g0 = *(const f32x4*)(gs5 + lane * 8), g1 = *(const f32x4*)(gs5 + lane * 8 + 4);
          u32x4 w; w.x = pack2(v[0] * rstd * g0[0], v[1] * rstd * g0[1]); w.y = pack2(v[2] * rstd * g0[2], v[3] * rstd * g0[3]);
          w.z = pack2(v[4] * rstd * g1[0], v[5] * rstd * g1[1]); w.w = pack2(v[6] * rstd * g1[2], v[7] * rstd * g1[3]);
          *(u32x4*)(mixed + (size_t)row * DM + 512 + lane * 8) = w; }
    }
}

constexpr int NPHASE = 29;
#ifndef ALIGN_UP
#define ALIGN_UP true
#endif
#ifndef ALIGN_GLU
#define ALIGN_GLU true
#endif
#ifndef ALIGN_IN
#define ALIGN_IN true
#endif
__device__ __forceinline__ void layer_phases(LAS unsigned char* lds, int lo, int hi, int L) {
#define PP() const ParamsG* pp = (const ParamsG*)__builtin_amdgcn_kernarg_segment_ptr(); asm volatile("" : "+s"(pp)); Params pl_; pl_.ws = (unsigned char*)pp->ws; pl_.out = (float*)pp->out; _Pragma("unroll") for (int i_ = 0; i_ < 30; ++i_) pl_.in[i_] = (const float*)pp->in[i_]; const Params& p = pl_; \
    float* H = (float*)(p.ws + WS_H); bf16_t* XN = (bf16_t*)(p.ws + WS_XN); bf16_t* ACT = (bf16_t*)(p.ws + WS_BIG); bf16_t* PROJ = (bf16_t*)(p.ws + WS_BIG); \
    bf16_t* MIXED = (bf16_t*)(p.ws + WS_BIG + SZ_PROJ); bf16_t* YG = XN; bf16_t* GL = XN + (size_t)MROWS * 512; const bf16_t* Wl = (const bf16_t*)(p.ws + WS_W) + (size_t)L * WL; \
    (void)H; (void)XN; (void)ACT; (void)PROJ; (void)MIXED; (void)YG; (void)GL; (void)Wl;
#define IN(k) (lo <= (k) && (k) < hi)
#define SEAM(k) do { if ((k) + 1 < hi) { if ((k) == 0) cg::this_grid().sync(); else { const ParamsG* pq = (const ParamsG*)__builtin_amdgcn_kernarg_segment_ptr(); asm volatile("" : "+s"(pq)); \
        XcdBarrier xb_; xb_.bar = (unsigned*)(unsigned char*)(pq->ws + WS_BAR); xb_.x = xb_xcc_id(); xb_.st = (volatile LAS unsigned*)(lds + 131072); xcd_barrier(xb_); } } } while (0)
    const int pb = 1 + 14 * L;
    if (IN(pb + 0)) { { PP(); EpiSwiGLU E{ACT}; run_gemm<EpiSwiGLU, ALIGN_UP>(lds, XN, Wl + WO_GU1, 2 * DFF, DM, E); } SEAM(pb + 0); }
    if (IN(pb + 1)) { { PP(); run_gemm_resid(lds, ACT, Wl + WO_D1, DM, DFF, H, 0.5f); } SEAM(pb + 1); }
    if (IN(pb + 2)) { { PP(); norm_rows<1>(p, lds, p.in[6] + L * DM, L); } SEAM(pb + 2); }
    if (IN(pb + 3)) { { PP(); EpiBf16 E{PROJ, PW}; run_gemm<EpiBf16, ALIGN_IN>(lds, XN, Wl + WO_IN, PW, DM, E); } SEAM(pb + 3); }
    if (IN(pb + 4)) { { PP(); const int wid = otid() >> 6;
        const DNBufs D = dn_bufs(p);
        int it = obid();
        for (; it < NDN; it += gridDim.x) dn_local_item(p, lds, it, L, PROJ, D);
        if (it < NDN + NDN) {
            S5Coef K; int gk = ((it - NDN) * 8 + wid) & 31; s5_load_coef<false>(p, L, gk, K);
            for (; it < NDN + NDN; it += gridDim.x) { const int item = (it - NDN) * 8 + wid;
                if ((item & 31) != gk) { gk = item & 31; s5_load_coef<false>(p, L, gk, K); }
                s5_item<false>(p, lds + wid * S5_LDSW, item, L, PROJ, K); __syncthreads(); } } }
        SEAM(pb + 4); }
    if (IN(pb + 5)) { { PP(); s5_carry_scan(p, L); } SEAM(pb + 5); }
    if (IN(pb + 6)) { { PP(); const int wid = otid() >> 6;
        const DNBufs D = dn_bufs(p);
        if (obid() < 8) dn_seq_block(lds, obid(), D);
        else { int it = obid() - 8;
            for (; it < 8 * NQB; it += gridDim.x - 8) sb_item(lds, it, PROJ, MIXED, p.in[8] + L * 64);
            if (it < 8 * NQB + NDN) {
                S5Coef K; int gk = ((it - 8 * NQB) * 8 + wid) & 31; s5_load_coef<true>(p, L, gk, K);
                for (; it < 8 * NQB + NDN; it += gridDim.x - 8) { const int item = (it - 8 * NQB) * 8 + wid;
                    if ((item & 31) != gk) { gk = item & 31; s5_load_coef<true>(p, L, gk, K); }
                    s5_item<true>(p, lds + wid * S5_LDSW, item, L, PROJ, K); __syncthreads(); } } } }
        SEAM(pb + 6); }
    if (IN(pb + 7)) { { PP(); EpiGLU E{YG, GL, p.in[22] + L * 512}; run_gemm<EpiGLU, ALIGN_GLU>(lds, YG, Wl + WO_GLU, 512, 512, E); } SEAM(pb + 7); }
    if (IN(pb + 8)) { { PP(); mix_finalize(p, L, PROJ, MIXED); } SEAM(pb + 8); }
    if (IN(pb + 9)) { { PP(); run_gemm_resid(lds, MIXED, Wl + WO_OUT, DM, DM, H, 1.0f); } SEAM(pb + 9); }
    if (IN(pb + 10)) { { PP(); norm_rows<0>(p, lds, p.in[25] + L * DM, L); } SEAM(pb + 10); }
    if (IN(pb + 11)) { { PP(); EpiSwiGLU E{ACT}; run_gemm<EpiSwiGLU, ALIGN_UP>(lds, XN, Wl + WO_GU2, 2 * DFF, DM, E); } SEAM(pb + 11); }
    if (IN(pb + 12)) { { PP(); run_gemm_resid(lds, ACT, Wl + WO_D2, DM, DFF, H, 0.5f); } SEAM(pb + 12); }
    if (IN(pb + 13)) { { PP(); if (L == 0) norm_rows<0>(p, lds, p.in[2] + DM, 1); else norm_rows<2>(p, lds, p.in[29], 1); } SEAM(pb + 13); }
}
__global__ void __launch_bounds__(NTHR, 2) hymba_fwd(Params p_arg) {
    extern __shared__ __attribute__((aligned(16))) unsigned char smem[];
    LAS unsigned char* lds = (LAS unsigned char*)smem;
    const int lo = p_arg.ph_lo, hi = p_arg.ph_hi;
    if (otid() < 4) ((LAS unsigned*)(lds + 131072))[otid()] = 0u;
    __syncthreads();
    (void)xcd_barrier_post((unsigned*)as_global(p_arg.ws + WS_BAR), (volatile LAS unsigned*)(lds + 131072));
    constexpr int L = 0;
    if (IN(0)) { { PP(); convert_weights(p, lds); s5_params(p); norm_rows<3>(p, lds, p.in[2], 0); } SEAM(0); }
#pragma nounroll
    for (int l = 0; l < 2; ++l) { int lq = l; asm volatile("" : "+s"(lq)); layer_phases(lds, lo, hi, lq); }
#undef IN
#undef SEAM
#undef PP
}

extern "C" void kernel_launch(void* const* d_in, const int* in_sizes, int n_in, void* d_out, int out_size, void* d_ws, size_t ws_size, hipStream_t stream) {
    static int grid = 0;
    if (grid == 0) {
        if (n_in != 30 || ws_size < WS_END) { fprintf(stderr, "kernel_launch: unexpected n_in %d or ws_size %zu (need %zu)\n", n_in, ws_size, (size_t)WS_END); grid = -1; return; }
        int dev = 0, cus = 0, per_cu = 0;
        hipGetDevice(&dev);
        hipDeviceGetAttribute(&cus, hipDeviceAttributeMultiprocessorCount, dev);
        if (hipFuncSetAttribute((const void*)hymba_fwd, hipFuncAttributeMaxDynamicSharedMemorySize, LDS_BYTES) != hipSuccess) { fprintf(stderr, "kernel_launch: hipFuncSetAttribute failed\n"); grid = -1; return; }
        if (hipOccupancyMaxActiveBlocksPerMultiprocessor(&per_cu, (const void*)hymba_fwd, NTHR, LDS_BYTES) != hipSuccess || per_cu < 1) { fprintf(stderr, "kernel_launch: occupancy query gave %d\n", per_cu); per_cu = 1; }
        (void)hipGetLastError();
        grid = cus * 1;
        fprintf(stderr, "kernel_launch: cus %d per_cu %d grid %d ws %zu\n", cus, per_cu, grid, ws_size);
    }
    if (grid < 0) return;
    (void)hipMemsetAsync((unsigned char*)d_ws + WS_BAR, 0, SZ_BAR, stream);
    Params p{};
    for (int i = 0; i < 30; ++i) p.in[i] = (const float*)d_in[i];
    p.out = (float*)d_out; p.ws = (unsigned char*)d_ws;
#if SINGLE_LAUNCH
    p.ph_lo = 0; p.ph_hi = NPHASE;
    void* args[] = {&p};
    hipError_t e = hipLaunchCooperativeKernel((const void*)hymba_fwd, dim3(grid), dim3(NTHR), args, LDS_BYTES, stream);
    if (e != hipSuccess) fprintf(stderr, "cooperative launch failed: %s (grid %d)\n", hipGetErrorString(e), grid);
#else
    for (int ph = 0; ph < NPHASE; ++ph) {
        p.ph_lo = ph; p.ph_hi = ph + 1;
        hipLaunchKernelGGL(hymba_fwd, dim3(grid), dim3(NTHR), LDS_BYTES, stream, p);
    }
#endif
}
```

```cpp
#include <hip/hip_runtime.h>
#include <hip/hip_cooperative_groups.h>
#include <cstdio>
namespace cg = cooperative_groups;

#ifndef SINGLE_LAUNCH
#define SINGLE_LAUNCH 1
#endif

__device__ __forceinline__ int otid() { int t = threadIdx.x; asm volatile("" : "+v"(t)); return t; }
__device__ __forceinline__ int obid() { int b = blockIdx.x; asm volatile("" : "+s"(b)); return b; }
namespace pg8 {
#define PG8_LAS __attribute__((address_space(3)))
typedef unsigned short bf16_t;
typedef short bf16x8 __attribute__((ext_vector_type(8)));
typedef float f32x4 __attribute__((ext_vector_type(4)));
typedef unsigned u32x4 __attribute__((ext_vector_type(4)));
constexpr int BM = 256, BK = 64, HALF = 128, HTB = HALF * BK * 2  , STAGE_BYTES = 8 * HTB, NXCD = 8, WGM = 4;

__host__ __device__ __forceinline__ int lds_byte(int r, int c) { const int st = (r >> 4) * 2 + (c >> 5), rr = r & 15, cc = c & 31, ob = rr * 64 + cc * 2; return st * 1024 + (ob ^ (((ob >> 9) & 1) << 5)); }
__host__ __device__ __forceinline__ void stage_rc(int b, int& R, int& C) { const int st = b / 1024, sb = b % 1024, swz = sb ^ (((sb >> 9) & 1) << 5); R = (st >> 1) * 16 + swz / 64; C = (st & 1) * 32 + (swz % 64) / 2; }
__host__ __device__ __forceinline__ int perm32(int rho) { const int n = rho >> 4, i = rho & 15; return 8 * (i >> 2) + 4 * n + (i & 3); }

struct Unit { int pm, pn, kp; };
struct Gemm { const bf16_t* A; const bf16_t* Bt; int M, N, K, ld; };

struct StaticOrder {
    int nM, nN, nwg, G, c;
    __host__ __device__ void init(int M, int N, int G_, int c_) { nM = M / BM; nN = N / BM; nwg = nM * nN; G = G_; c = c_; }
    __host__ __device__ bool next(int i, Unit& u) const {
        const long L = (long)i * G + c; if (L >= nwg) return false;
        int wgid = (int)L; { const int q = nwg / NXCD, r = nwg % NXCD, xcd = wgid % NXCD, off = wgid / NXCD; wgid = (xcd < r ? xcd * (q + 1) : r * (q + 1) + (xcd - r) * q) + off; }
        const int nig = WGM * nN, gid = wgid / nig, fm = gid * WGM, gsz = (nM - fm) < WGM ? (nM - fm) : WGM;
        u.pm = fm + ((wgid % nig) % gsz); u.pn = (wgid % nig) / gsz; u.kp = 0; return true;
    }
    __device__ __forceinline__ void a_ready(const Unit&) const {}
    __device__ __forceinline__ void done(const Unit&) const {}
};
struct HeadOrder : StaticOrder {
    int nfull;
    __host__ __device__ void init2(int M, int N, int G_, int c_) { init(M, N, G_, c_); nfull = (nwg / G_) * G_; }
    __host__ __device__ bool next(int i, Unit& u) const { if ((long)i * G + c >= nfull) return false; return StaticOrder::next(i, u); }
};
struct TailOrder : StaticOrder {
    int nfull, np;
    __host__ __device__ void init2(int M, int N, int G_, int c_, int np_) { init(M, N, G_, c_); nfull = (nwg / G_) * G_; np = np_; }
    __host__ __device__ bool next(int i, Unit& u) const {
        if (i > 0) return false;
        const int t = nfull + c / np; if (t >= nwg) return false;
        StaticOrder s2 = *this; s2.c = t % G; if (!s2.StaticOrder::next(t / G, u)) return false;
        u.kp = c % np; return true;
    }
};
__device__ __forceinline__ unsigned cvt_pk_bf16(float lo, float hi) { unsigned r; asm volatile("v_cvt_pk_bf16_f32 %0, %1, %2" : "=v"(r) : "v"(lo), "v"(hi)); return r; }
template <class Epi, class Sched, bool STAMP = false>
__device__ __forceinline__ void gemm_phase(PG8_LAS unsigned char* lds, const Gemm g, const Sched& S, const Epi& E, unsigned long long* stamps) {
    const int tid = otid(), wid = __builtin_amdgcn_readfirstlane(tid >> 6), lane = tid & 63, wr = wid >> 2, wc = wid & 3, fr = lane & 15, fq = lane >> 4;
    const int K = g.K, nt = K / BK, ld = g.ld;
    unsigned voffA[2], voffB[2];
#pragma unroll
    for (int i = 0; i < 2; ++i) { int R, C; stage_rc(tid * 16 + i * 8192, R, C); const int Rb = E.perm() ? ((R & ~31) + perm32(R & 31)) : R;
        voffA[i] = (unsigned)(R * ld + C) * 2u; voffB[i] = (unsigned)(Rb * ld + C) * 2u; }
    const size_t kstep = (size_t)(BK * 2);
    const size_t hstep = (size_t)HALF * ld * 2;
    const size_t tstep = 2 * hstep;
    const unsigned ldsw = (unsigned)wid * 1024u;
    const int aoff = lds_byte(wr * 64 + fr, fq * 8), boff = lds_byte(wc * 32 + fr, fq * 8);
#define PG8_SA(b, h) (((b) * 2 + (h)) * HTB)
#define PG8_SB(b, h) ((4 + (b) * 2 + (h)) * HTB)
#define PG8_STAGE(bufoff, gbase, voff) do { _Pragma("unroll") for (int _i = 0; _i < 2; ++_i) \
        __builtin_amdgcn_global_load_lds((const unsigned*)((const char*)(gbase) + (voff)[_i]), (PG8_LAS unsigned*)(lds + (bufoff) + ldsw + _i * 8192), 16, 0, 0); } while (0)
#define PG8_LDA(dst, b, h) do { _Pragma("unroll") for (int m = 0; m < 4; ++m) _Pragma("unroll") for (int k = 0; k < 2; ++k) dst[m][k] = *(const PG8_LAS bf16x8*)(lds + PG8_SA(b, h) + aoff + m * 2048 + k * 1024); } while (0)
#define PG8_LDB(dst, b, h) do { _Pragma("unroll") for (int n = 0; n < 2; ++n) _Pragma("unroll") for (int k = 0; k < 2; ++k) dst[n][k] = *(const PG8_LAS bf16x8*)(lds + PG8_SB(b, h) + boff + n * 2048 + k * 1024); } while (0)
#define PG8_MMA(ai, bj, At, Bt) do { __builtin_amdgcn_s_setprio(1); _Pragma("unroll") for (int m = 0; m < 4; ++m) _Pragma("unroll") for (int n = 0; n < 2; ++n) _Pragma("unroll") for (int k = 0; k < 2; ++k) \
        acc[ai][bj][m][n] = __builtin_amdgcn_mfma_f32_16x16x32_bf16(Bt[n][k], At[m][k], acc[ai][bj][m][n], 0, 0, 0); __builtin_amdgcn_s_setprio(0); } while (0)
#define PG8_WAIT_V(n) asm volatile("s_waitcnt vmcnt(" #n ")" ::: "memory")
#define PG8_WAIT_L(n) asm volatile("s_waitcnt lgkmcnt(" #n ")" ::: "memory")
#define PG8_BAR __builtin_amdgcn_s_barrier()
#define PG8_SCHED __builtin_amdgcn_sched_barrier(0)
    Unit cur, nxt; int ui = 0;
    if (!S.next(0, cur)) return;
    f32x4 acc[2][2][4][2];
#pragma unroll
    for (int a = 0; a < 2; ++a)
#pragma unroll
        for (int b = 0; b < 2; ++b)
#pragma unroll
            for (int m = 0; m < 4; ++m)
#pragma unroll
                for (int n = 0; n < 2; ++n) acc[a][b][m][n] = (f32x4){0.f, 0.f, 0.f, 0.f};
    bf16x8 At[4][2], B0[2][2], B1[2][2];
    const char* cA = (const char*)g.A + (size_t)cur.pm * tstep + (size_t)cur.kp * K * 2; const char* cB = (const char*)g.Bt + (size_t)cur.pn * tstep + (size_t)cur.kp * K * 2;
    S.a_ready(cur);
    PG8_STAGE(PG8_SB(0, 0), cB, voffB); PG8_STAGE(PG8_SA(0, 0), cA, voffA); PG8_STAGE(PG8_SB(0, 1), cB + hstep, voffB); PG8_STAGE(PG8_SA(0, 1), cA + hstep, voffA);
    if (wr == 1) PG8_BAR;
    PG8_WAIT_V(4); PG8_BAR;
    PG8_STAGE(PG8_SB(1, 0), cB + kstep, voffB); PG8_STAGE(PG8_SA(1, 0), cA + kstep, voffA); PG8_STAGE(PG8_SB(1, 1), cB + hstep + kstep, voffB);
    PG8_WAIT_V(6); PG8_BAR;
    for (;;) {
        const bool has_next = S.next(ui + 1, nxt);
        const char* nA = has_next ? (const char*)g.A + (size_t)nxt.pm * tstep + (size_t)nxt.kp * K * 2 : cA; const char* nB = has_next ? (const char*)g.Bt + (size_t)nxt.pn * tstep + (size_t)nxt.kp * K * 2 : cB;
        for (int t = 0; t < nt; t += 2) {
            const bool last = (t == nt - 2);
            const char* a1 = cA + (size_t)(t + 1) * kstep;
            const char* a2 = last ? nA : cA + (size_t)(t + 2) * kstep; const char* b2 = last ? nB : cB + (size_t)(t + 2) * kstep;
            const char* a3 = a2 + kstep; const char* b3 = b2 + kstep;
            if (last && has_next) S.a_ready(nxt);
            PG8_LDB(B0, 0, 0); PG8_SCHED; PG8_LDA(At, 0, 0); PG8_STAGE(PG8_SA(1, 1), a1 + hstep, voffA);
            PG8_WAIT_L(8); PG8_BAR; PG8_WAIT_L(0); PG8_MMA(0, 0, At, B0); PG8_BAR; PG8_SCHED;
            PG8_LDB(B1, 0, 1); PG8_STAGE(PG8_SB(0, 0), b2, voffB);
            PG8_BAR; PG8_WAIT_L(0); PG8_MMA(0, 1, At, B1); PG8_BAR;
            PG8_LDA(At, 0, 1); PG8_STAGE(PG8_SA(0, 0), a2, voffA);
            PG8_BAR; PG8_WAIT_L(0); PG8_MMA(1, 0, At, B0); PG8_BAR; PG8_SCHED;
            PG8_STAGE(PG8_SB(0, 1), b2 + hstep, voffB);
            PG8_WAIT_V(6); PG8_BAR; PG8_MMA(1, 1, At, B1); PG8_BAR;
            PG8_LDB(B0, 1, 0); PG8_SCHED; PG8_LDA(At, 1, 0); PG8_STAGE(PG8_SA(0, 1), a2 + hstep, voffA);
            PG8_WAIT_L(8); PG8_BAR; PG8_WAIT_L(0); PG8_MMA(0, 0, At, B0); PG8_BAR; PG8_SCHED;
            PG8_LDB(B1, 1, 1); PG8_STAGE(PG8_SB(1, 0), b3, voffB);
            PG8_BAR; PG8_WAIT_L(0); PG8_MMA(0, 1, At, B1); PG8_BAR;
            PG8_LDA(At, 1, 1); PG8_STAGE(PG8_SA(1, 0), a3, voffA);
            PG8_BAR; PG8_WAIT_L(0); PG8_MMA(1, 0, At, B0); PG8_BAR; PG8_SCHED;
            PG8_STAGE(PG8_SB(1, 1), b3 + hstep, voffB);
            PG8_WAIT_V(6); PG8_BAR; PG8_MMA(1, 1, At, B1); PG8_BAR;
        }
        if constexpr (!Epi::AFTER_DRAIN) { E(acc, cur, wr, wc, fr, fq); S.done(cur); }
        if (!has_next) break;
#pragma unroll
        for (int a = 0; a < 2; ++a)
#pragma unroll
            for (int b = 0; b < 2; ++b)
#pragma unroll
                for (int m = 0; m < 4; ++m)
#pragma unroll
                    for (int n = 0; n < 2; ++n) acc[a][b][m][n] = (f32x4){0.f, 0.f, 0.f, 0.f};
        cur = nxt; cA = nA; cB = nB; ++ui;
    }
    PG8_WAIT_V(0);
    if (wr == 0) PG8_BAR;
    PG8_BAR;
    if constexpr (Epi::AFTER_DRAIN) { E.fused(acc, cur, wr, wc, fr, fq, lds, wid, lane); S.done(cur); }
#undef PG8_SA
#undef PG8_SB
#undef PG8_STAGE
#undef PG8_LDA
#undef PG8_LDB
#undef PG8_MMA
#undef PG8_WAIT_V
#undef PG8_WAIT_L
#undef PG8_BAR
#undef PG8_SCHED
}
template <class Epi, class Sched, bool ALIGN_EPI = false, bool SP2 = false>
__device__ __forceinline__ void gemm_phase2(PG8_LAS unsigned char* lds, const Gemm g, const Sched& S, const Epi& E) {
    const int tid = otid(), wid = __builtin_amdgcn_readfirstlane(tid >> 6), lane = tid & 63, wr = wid >> 2, wc = wid & 3, fr = lane & 15, fq = lane >> 4;
    const int K = g.K, nt = K / BK, ld = g.ld;
    unsigned voffA[2], voffB[2];
#pragma unroll
    for (int i = 0; i < 2; ++i) { int R, C; stage_rc(tid * 16 + i * 8192, R, C); const int Rb = E.perm() ? ((R & ~31) + perm32(R & 31)) : R;
        voffA[i] = (unsigned)(R * ld + C) * 2u; voffB[i] = (unsigned)(Rb * ld + C) * 2u; }
    const size_t kstep = (size_t)(BK * 2);
    const size_t hstep = (size_t)HALF * ld * 2;
    const size_t tstep = 2 * hstep;
    const unsigned ldsw = (unsigned)wid * 1024u;
    const int aoff = lds_byte(wr * 64 + fr, fq * 8), boff = lds_byte(wc * 32 + fr, fq * 8);
#define PG8_SA(b, h) (((b) * 2 + (h)) * HTB)
#define PG8_SB(b, h) ((4 + (b) * 2 + (h)) * HTB)
#define PG8_STAGE(bufoff, gbase, voff) do { _Pragma("unroll") for (int _i = 0; _i < 2; ++_i) \
        __builtin_amdgcn_global_load_lds((const unsigned*)((const char*)(gbase) + (voff)[_i]), (PG8_LAS unsigned*)(lds + (bufoff) + ldsw + _i * 8192), 16, 0, 0); } while (0)
#define PG8_LDA(dst, b, h) do { _Pragma("unroll") for (int m = 0; m < 4; ++m) _Pragma("unroll") for (int k = 0; k < 2; ++k) dst[m][k] = *(const PG8_LAS bf16x8*)(lds + PG8_SA(b, h) + aoff + m * 2048 + k * 1024); } while (0)
#define PG8_LDB(dst, b, h) do { _Pragma("unroll") for (int n = 0; n < 2; ++n) _Pragma("unroll") for (int k = 0; k < 2; ++k) dst[n][k] = *(const PG8_LAS bf16x8*)(lds + PG8_SB(b, h) + boff + n * 2048 + k * 1024); } while (0)
#define PG8_MMA(ai, bj, At, Bt) do { __builtin_amdgcn_s_setprio(1); _Pragma("unroll") for (int m = 0; m < 4; ++m) _Pragma("unroll") for (int n = 0; n < 2; ++n) _Pragma("unroll") for (int k = 0; k < 2; ++k) \
        acc[ai][bj][m][n] = __builtin_amdgcn_mfma_f32_16x16x32_bf16(Bt[n][k], At[m][k], acc[ai][bj][m][n], 0, 0, 0); __builtin_amdgcn_s_setprio(0); } while (0)
#define PG8_WAIT_V(n) asm volatile("s_waitcnt vmcnt(" #n ")" ::: "memory")
#define PG8_WAIT_L(n) asm volatile("s_waitcnt lgkmcnt(" #n ")" ::: "memory")
#define PG8_BAR __builtin_amdgcn_s_barrier()
#define PG8_SCHED __builtin_amdgcn_sched_barrier(0)
    Unit cur, nxt; int ui = 0;
    if (!S.next(0, cur)) return;
    f32x4 acc[2][2][4][2];
#pragma unroll
    for (int a = 0; a < 2; ++a)
#pragma unroll
        for (int b = 0; b < 2; ++b)
#pragma unroll
            for (int m = 0; m < 4; ++m)
#pragma unroll
                for (int n = 0; n < 2; ++n) acc[a][b][m][n] = (f32x4){0.f, 0.f, 0.f, 0.f};
    bf16x8 At[4][2], B0[2][2], B1[2][2];
    const char* cA = (const char*)g.A + (size_t)cur.pm * tstep + (size_t)cur.kp * K * 2; const char* cB = (const char*)g.Bt + (size_t)cur.pn * tstep + (size_t)cur.kp * K * 2;
    S.a_ready(cur);
    if constexpr (SP2) {
        PG8_STAGE(PG8_SB(0, 0), cB, voffB); PG8_STAGE(PG8_SB(0, 1), cB + hstep, voffB); PG8_STAGE(PG8_SA(0, 0), cA, voffA); PG8_STAGE(PG8_SA(0, 1), cA + hstep, voffA);
        if (wr == 1) PG8_BAR;
        PG8_WAIT_V(2); PG8_BAR;
        PG8_STAGE(PG8_SB(1, 0), cB + kstep, voffB); PG8_STAGE(PG8_SA(1, 0), cA + kstep, voffA); PG8_STAGE(PG8_SB(1, 1), cB + hstep + kstep, voffB);
        PG8_WAIT_V(6); PG8_BAR;
    } else {
        PG8_STAGE(PG8_SB(0, 0), cB, voffB); PG8_STAGE(PG8_SA(0, 0), cA, voffA); PG8_STAGE(PG8_SB(0, 1), cB + hstep, voffB); PG8_STAGE(PG8_SA(0, 1), cA + hstep, voffA);
        if (wr == 1) PG8_BAR;
        PG8_WAIT_V(4); PG8_BAR;
        PG8_STAGE(PG8_SB(1, 0), cB + kstep, voffB); PG8_STAGE(PG8_SA(1, 0), cA + kstep, voffA); PG8_STAGE(PG8_SB(1, 1), cB + hstep + kstep, voffB);
        PG8_WAIT_V(6); PG8_BAR;
    }
    for (;;) {
        const bool has_next = S.next(ui + 1, nxt);
        const char* nA = has_next ? (const char*)g.A + (size_t)nxt.pm * tstep + (size_t)nxt.kp * K * 2 : cA; const char* nB = has_next ? (const char*)g.Bt + (size_t)nxt.pn * tstep + (size_t)nxt.kp * K * 2 : cB;
        for (int t = 0; t < nt; t += 2) {
            const bool last = (t == nt - 2);
            const char* a1 = cA + (size_t)(t + 1) * kstep;
            const char* a2 = last ? nA : cA + (size_t)(t + 2) * kstep; const char* b2 = last ? nB : cB + (size_t)(t + 2) * kstep;
            const char* a3 = a2 + kstep; const char* b3 = b2 + kstep;
            if (last && has_next) S.a_ready(nxt);
            if constexpr (SP2) {
            PG8_LDB(B0, 0, 0); PG8_LDB(B1, 0, 1); PG8_SCHED; PG8_LDA(At, 0, 0); PG8_STAGE(PG8_SA(1, 1), a1 + hstep, voffA);
            PG8_WAIT_V(8); PG8_WAIT_L(0); PG8_BAR; PG8_MMA(0, 0, At, B0); PG8_MMA(0, 1, At, B1); PG8_BAR; PG8_SCHED;
            PG8_LDA(At, 0, 1); PG8_STAGE(PG8_SB(0, 0), b2, voffB); PG8_STAGE(PG8_SB(0, 1), b2 + hstep, voffB); PG8_STAGE(PG8_SA(0, 0), a2, voffA);
            PG8_WAIT_V(8); PG8_WAIT_L(0); PG8_BAR; PG8_MMA(1, 0, At, B0); PG8_MMA(1, 1, At, B1); PG8_BAR; PG8_SCHED;
            PG8_LDB(B0, 1, 0); PG8_LDB(B1, 1, 1); PG8_SCHED; PG8_LDA(At, 1, 0); PG8_STAGE(PG8_SA(0, 1), a2 + hstep, voffA);
            PG8_WAIT_V(8); PG8_WAIT_L(0); PG8_BAR; PG8_MMA(0, 0, At, B0); PG8_MMA(0, 1, At, B1); PG8_BAR; PG8_SCHED;
            PG8_LDA(At, 1, 1); PG8_STAGE(PG8_SB(1, 0), b3, voffB); PG8_STAGE(PG8_SB(1, 1), b3 + hstep, voffB); PG8_STAGE(PG8_SA(1, 0), a3, voffA);
            PG8_WAIT_V(8); PG8_WAIT_L(0); PG8_BAR; PG8_MMA(1, 0, At, B0); PG8_MMA(1, 1, At, B1); PG8_BAR; PG8_SCHED;
            } else {
            PG8_LDB(B0, 0, 0); PG8_SCHED; PG8_LDA(At, 0, 0); PG8_STAGE(PG8_SA(1, 1), a1 + hstep, voffA);
            PG8_WAIT_L(8); PG8_BAR; PG8_WAIT_L(0); PG8_MMA(0, 0, At, B0); PG8_BAR; PG8_SCHED;
            PG8_LDB(B1, 0, 1); PG8_STAGE(PG8_SB(0, 0), b2, voffB);
            PG8_BAR; PG8_WAIT_L(0); PG8_MMA(0, 1, At, B1); PG8_BAR;
            PG8_LDA(At, 0, 1); PG8_STAGE(PG8_SA(0, 0), a2, voffA);
            PG8_BAR; PG8_WAIT_L(0); PG8_MMA(1, 0, At, B0); PG8_BAR; PG8_SCHED;
            PG8_STAGE(PG8_SB(0, 1), b2 + hstep, voffB);
            PG8_WAIT_V(6); PG8_BAR; PG8_MMA(1, 1, At, B1); PG8_BAR;
            PG8_LDB(B0, 1, 0); PG8_SCHED; PG8_LDA(At, 1, 0); PG8_STAGE(PG8_SA(0, 1), a2 + hstep, voffA);
            PG8_WAIT_L(8); PG8_BAR; PG8_WAIT_L(0); PG8_MMA(0, 0, At, B0); PG8_BAR; PG8_SCHED;
            PG8_LDB(B1, 1, 1); PG8_STAGE(PG8_SB(1, 0), b3, voffB);
            PG8_BAR; PG8_WAIT_L(0); PG8_MMA(0, 1, At, B1); PG8_BAR;
            PG8_LDA(At, 1, 1); PG8_STAGE(PG8_SA(1, 0), a3, voffA);
            PG8_BAR; PG8_WAIT_L(0); PG8_MMA(1, 0, At, B0); PG8_BAR; PG8_SCHED;
            PG8_STAGE(PG8_SB(1, 1), b3 + hstep, voffB);
            PG8_WAIT_V(6); PG8_BAR; PG8_MMA(1, 1, At, B1); PG8_BAR;
            }
        }
        if constexpr (ALIGN_EPI) { if (wr == 0) PG8_BAR; }
        if constexpr (!Epi::AFTER_DRAIN) { E(acc, cur, wr, wc, fr, fq); S.done(cur); }
        if (!has_next) break;
#pragma unroll
        for (int a = 0; a < 2; ++a)
#pragma unroll
            for (int b = 0; b < 2; ++b)
#pragma unroll
                for (int m = 0; m < 4; ++m)
#pragma unroll
                    for (int n = 0; n < 2; ++n) acc[a][b][m][n] = (f32x4){0.f, 0.f, 0.f, 0.f};
        cur = nxt; cA = nA; cB = nB; ++ui;
        if constexpr (ALIGN_EPI) { if (wr == 1) PG8_BAR; }
    }
    PG8_WAIT_V(0);
    if constexpr (!ALIGN_EPI) { if (wr == 0) PG8_BAR; }
    PG8_BAR;
    if constexpr (Epi::AFTER_DRAIN) { E.fused(acc, cur, wr, wc, fr, fq, lds, wid, lane); S.done(cur); }
#undef PG8_SA
#undef PG8_SB
#undef PG8_STAGE
#undef PG8_LDA
#undef PG8_LDB
#undef PG8_MMA
#undef PG8_WAIT_V
#undef PG8_WAIT_L
#undef PG8_BAR
#undef PG8_SCHED
}
}

#define LAS __attribute__((address_space(3)))
typedef unsigned short bf16_t;
typedef short bf16x8 __attribute__((ext_vector_type(8)));
typedef float f32x4 __attribute__((ext_vector_type(4)));
typedef unsigned u32x4 __attribute__((ext_vector_type(4)));
typedef unsigned u32x2 __attribute__((ext_vector_type(2)));

constexpr int DM = 1024, DFF = 2816, SEQ = 16384, PADF = 112, LP = 16512, MROWS = 33024, PW = 2304, INW = 2312;
constexpr int NCH = 258;
constexpr int NQB = 129;
constexpr int NTHR = 512;
constexpr int LDS_BYTES = 131072 + 16;

constexpr size_t WS_H = 0;
constexpr size_t SZ_H = (size_t)MROWS * DM * 4;
constexpr size_t WS_XN = WS_H + SZ_H;
constexpr size_t SZ_XN = (size_t)MROWS * DM * 2;
constexpr size_t WS_BIG = WS_XN + SZ_XN;
constexpr size_t SZ_PROJ = (size_t)MROWS * PW * 2;
constexpr size_t SZ_BIG = SZ_PROJ + SZ_XN;
constexpr size_t WS_W = WS_BIG + SZ_BIG;
constexpr size_t WL = 20971520;
constexpr size_t SZ_W = WL * 2 * 2;
constexpr size_t WS_BA = WS_W + SZ_W;
constexpr size_t SZ_BA = (size_t)MROWS * 8 * 4;
constexpr size_t WS_E = WS_BA + SZ_BA;
constexpr size_t SZ_E = (size_t)2 * NCH * 32 * 64 * 2 * 4;
constexpr size_t WS_S5P = WS_E + SZ_E;
constexpr size_t S5P_L = 73728;
constexpr size_t SZ_S5P = 2 * S5P_L * 4;
constexpr size_t WS_BAR = WS_S5P + SZ_S5P;
constexpr size_t SZ_BAR = 16384;
constexpr size_t WS_CIN = WS_BAR + SZ_BAR;
constexpr size_t WS_END = WS_CIN + SZ_E;
static_assert(WS_END <= 536870912ull, "workspace too large");
static_assert(SZ_BIG >= (size_t)MROWS * DFF * 2, "act must fit");
constexpr size_t WO_GU1 = 0, WO_D1 = 5767168, WO_IN = 8650752, WO_GLU = 11010048, WO_OUT = 11272192, WO_GU2 = 12320768, WO_D2 = 18087936;
constexpr int NDN = 8 * NCH;
constexpr size_t DO_W = 0, DO_QG = 16908288, DO_ATT = 2 * 16908288ull, DO_KT = 3 * 16908288ull, DO_UT = 4 * 16908288ull, DO_EGL = 5 * 16908288ull;
constexpr size_t DO_ODN = DO_EGL + 8448;
static_assert(DO_ODN + (size_t)MROWS * 256 * 4 <= 134217728ull, "d_out scratch too large");

template <class T> __device__ __forceinline__ T* as_global(T* q) {
#if defined(__HIP_DEVICE_COMPILE__)
    __builtin_assume(!__builtin_amdgcn_is_shared((const __attribute__((address_space(0))) void*)q)); __builtin_assume(!__builtin_amdgcn_is_private((const __attribute__((address_space(0))) void*)q));
#endif
    return q; }
#define GAS __attribute__((address_space(1)))
struct ParamsG { const GAS float* in[30]; GAS float* out; GAS unsigned char* ws; int ph_lo, ph_hi; };
struct Params { const float* in[30]; float* out; unsigned char* ws; int ph_lo, ph_hi; };

typedef float f32x2_t __attribute__((ext_vector_type(2)));
typedef __bf16 bf16x2_t __attribute__((ext_vector_type(2)));
__device__ __forceinline__ unsigned pack2(float lo, float hi) { const f32x2_t v = {lo, hi}; const bf16x2_t b = __builtin_convertvector(v, bf16x2_t); return __builtin_bit_cast(unsigned, b); }
__device__ __forceinline__ bf16_t f2bf(float f) { return (bf16_t)(pack2(f, 0.f) & 0xffffu); }
__device__ __forceinline__ float bf2f(bf16_t b) { return __uint_as_float(((unsigned)b) << 16); }
__device__ __forceinline__ float bflo(unsigned w) { return __uint_as_float(w << 16); }
__device__ __forceinline__ float bfhi(unsigned w) { return __uint_as_float(w & 0xffff0000u); }
__device__ __forceinline__ float softplus_fast(float x) { return fmaxf(x, 0.f) + __logf(1.f + __expf(-fabsf(x))); }
__device__ __forceinline__ float sigmoid_fast(float x) { return __builtin_amdgcn_rcpf(1.f + __expf(-x)); }
__device__ __forceinline__ float silu_fast(float x) { return x * __builtin_amdgcn_rcpf(1.f + __expf(-x)); }
__device__ __forceinline__ f32x4 mfma16(bf16x8 a, bf16x8 b, f32x4 c) { return __builtin_amdgcn_mfma_f32_16x16x32_bf16(a, b, c, 0, 0, 0); }
#define WAVE_LDS_SYNC() do { asm volatile("s_waitcnt lgkmcnt(0)" ::: "memory"); __builtin_amdgcn_wave_barrier(); } while (0)

#ifndef GEMM_SP2
#define GEMM_SP2 true
#endif
#ifndef ALIGN_RES
#define ALIGN_RES true
#endif
#ifndef GEMM_ALIGN
#define GEMM_ALIGN false
#endif
struct EpiSwiGLU {
    static constexpr bool PERM = true, AFTER_DRAIN = false; __device__ __forceinline__ constexpr bool perm() const { return true; }
    bf16_t* O;
    __device__ __forceinline__ void operator()(const f32x4 (&acc)[2][2][4][2], const pg8::Unit& u, int wr, int wc, int fr, int fq) const {
        const int row0 = u.pm * 256 + wr * 64 + fr, j0 = u.pn * 128 + wc * 32 + 8 * fq;
#pragma unroll
        for (int ai = 0; ai < 2; ++ai)
#pragma unroll
            for (int m = 0; m < 4; ++m) {
                const f32x4 g0 = acc[ai][0][m][0], g1 = acc[ai][0][m][1], u0 = acc[ai][1][m][0], u1 = acc[ai][1][m][1];
                u32x4 w;
                w.x = pack2(silu_fast(g0[0]) * u0[0], silu_fast(g0[1]) * u0[1]); w.y = pack2(silu_fast(g0[2]) * u0[2], silu_fast(g0[3]) * u0[3]);
                w.z = pack2(silu_fast(g1[0]) * u1[0], silu_fast(g1[1]) * u1[1]); w.w = pack2(silu_fast(g1[2]) * u1[2], silu_fast(g1[3]) * u1[3]);
                *(u32x4*)(O + (size_t)(row0 + ai * 128 + m * 16) * DFF + j0) = w;
            }
    }
};
struct EpiResid {
    static constexpr bool PERM = false, AFTER_DRAIN = false; __device__ __forceinline__ constexpr bool perm() const { return false; }
    float* H; float scale; int atomic;
    __device__ __forceinline__ void operator()(const f32x4 (&acc)[2][2][4][2], const pg8::Unit& u, int wr, int wc, int fr, int fq) const {
        const int row0 = u.pm * 256 + wr * 64 + fr, col0 = u.pn * 256 + wc * 32 + 4 * fq;
#pragma unroll
        for (int ai = 0; ai < 2; ++ai)
#pragma unroll
            for (int m = 0; m < 4; ++m) { float* rowp = H + (size_t)(row0 + ai * 128 + m * 16) * DM + col0;
#pragma unroll
                for (int bj = 0; bj < 2; ++bj)
#pragma unroll
                    for (int n = 0; n < 2; ++n) { f32x4* q = (f32x4*)(rowp + bj * 128 + n * 16); const f32x4 v = acc[ai][bj][m][n] * scale;
                        if (atomic) { float* qf = (float*)q; unsafeAtomicAdd(qf, v[0]); unsafeAtomicAdd(qf + 1, v[1]); unsafeAtomicAdd(qf + 2, v[2]); unsafeAtomicAdd(qf + 3, v[3]); }
                        else *q = *q + v; } }
    }
};
struct EpiBf16 {
    static constexpr bool PERM = true, AFTER_DRAIN = false; __device__ __forceinline__ constexpr bool perm() const { return true; }
    bf16_t* O; int ldc;
    __device__ __forceinline__ void operator()(const f32x4 (&acc)[2][2][4][2], const pg8::Unit& u, int wr, int wc, int fr, int fq) const {
        const int row0 = u.pm * 256 + wr * 64 + fr, col0 = u.pn * 256 + wc * 32 + 8 * fq;
#pragma unroll
        for (int ai = 0; ai < 2; ++ai)
#pragma unroll
            for (int m = 0; m < 4; ++m) { bf16_t* rowp = O + (size_t)(row0 + ai * 128 + m * 16) * ldc + col0;
#pragma unroll
                for (int bj = 0; bj < 2; ++bj) { const f32x4 v0 = acc[ai][bj][m][0], v1 = acc[ai][bj][m][1];
                    u32x4 w; w.x = pack2(v0[0], v0[1]); w.y = pack2(v0[2], v0[3]); w.z = pack2(v1[0], v1[1]); w.w = pack2(v1[2], v1[3]);
                    *(u32x4*)(rowp + bj * 128) = w; } }
    }
};
struct EpiGLU {
    static constexpr bool PERM = true, AFTER_DRAIN = false; __device__ __forceinline__ constexpr bool perm() const { return true; }
    const bf16_t* Y; bf16_t* O; const float* bias;
    __device__ __forceinline__ void operator()(const f32x4 (&acc)[2][2][4][2], const pg8::Unit& u, int wr, int wc, int fr, int fq) const {
        const int row0 = u.pm * 256 + wr * 64 + fr, col0 = u.pn * 256 + wc * 32 + 8 * fq;
#pragma unroll
        for (int ai = 0; ai < 2; ++ai)
#pragma unroll
            for (int m = 0; m < 4; ++m) { const size_t ro = (size_t)(row0 + ai * 128 + m * 16) * 512 + col0;
#pragma unroll
                for (int bj = 0; bj < 2; ++bj) { const f32x4 v0 = acc[ai][bj][m][0], v1 = acc[ai][bj][m][1];
                    const u32x4 yv = *(const u32x4*)(Y + ro + bj * 128);
                    const f32x4 b0 = *(const f32x4*)(bias + col0 + bj * 128), b1 = *(const f32x4*)(bias + col0 + bj * 128 + 4);
                    u32x4 w;
                    w.x = pack2(bflo(yv.x) * sigmoid_fast(v0[0] + b0[0]), bfhi(yv.x) * sigmoid_fast(v0[1] + b0[1]));
                    w.y = pack2(bflo(yv.y) * sigmoid_fast(v0[2] + b0[2]), bfhi(yv.y) * sigmoid_fast(v0[3] + b0[3]));
                    w.z = pack2(bflo(yv.z) * sigmoid_fast(v1[0] + b1[0]), bfhi(yv.z) * sigmoid_fast(v1[1] + b1[1]));
                    w.w = pack2(bflo(yv.w) * sigmoid_fast(v1[2] + b1[2]), bfhi(yv.w) * sigmoid_fast(v1[3] + b1[3]));
                    *(u32x4*)(O + ro + bj * 128) = w; } }
    }
};
struct EpiGen {
    static constexpr bool AFTER_DRAIN = false;
    int mode;
    void* O; const bf16_t* Y; const float* bias; float scale; int ldc;
    __device__ __forceinline__ bool perm() const { return mode != 1; }
    __device__ __forceinline__ void operator()(const f32x4 (&acc)[2][2][4][2], const pg8::Unit& u, int wr, int wc, int fr, int fq) const {
        if (mode == 0) { EpiSwiGLU e{(bf16_t*)O}; e(acc, u, wr, wc, fr, fq); }
        else if (mode == 1) { EpiResid e{(float*)O, scale, 0}; e(acc, u, wr, wc, fr, fq); }
        else if (mode == 2) { EpiBf16 e{(bf16_t*)O, ldc}; e(acc, u, wr, wc, fr, fq); }
        else { EpiGLU e{Y, (bf16_t*)O, bias}; e(acc, u, wr, wc, fr, fq); }
    }
};
__device__ __forceinline__ void run_gemm(LAS unsigned char* lds, const bf16_t* A, const bf16_t* Bt, int N, int K, const EpiGen& E) {
    pg8::Gemm g{A, Bt, MROWS, N, K, K}; pg8::StaticOrder S; S.init(MROWS, N, (int)gridDim.x, obid());
    pg8::gemm_phase2<EpiGen, pg8::StaticOrder, GEMM_ALIGN, GEMM_SP2>(lds, g, S, E);
}

template <class Epi, bool ALIGN = GEMM_ALIGN> __device__ __forceinline__ void run_gemm(LAS unsigned char* lds, const bf16_t* A, const bf16_t* Bt, int N, int K, const Epi& E) {
    pg8::Gemm g{A, Bt, MROWS, N, K, K}; pg8::StaticOrder S; S.init(MROWS, N, (int)gridDim.x, obid());
    pg8::gemm_phase2<Epi, pg8::StaticOrder, ALIGN, GEMM_SP2>(lds, g, S, E);
}
__device__ __forceinline__ void run_gemm_resid(LAS unsigned char* lds, const bf16_t* A, const bf16_t* Bt, int N, int K, float* H, float scale) {
    { pg8::Gemm g{A, Bt, MROWS, N, K, K}; pg8::HeadOrder S; S.init2(MROWS, N, (int)gridDim.x, obid()); EpiResid E{H, scale, 0};
      pg8::gemm_phase2<EpiResid, pg8::HeadOrder, ALIGN_RES, GEMM_SP2>(lds, g, S, E); }
    { pg8::Gemm g{A, Bt, MROWS, N, 256, K}; pg8::TailOrder S; S.init2(MROWS, N, (int)gridDim.x, obid(), K / 256); EpiResid E{H, scale, 1};
      pg8::gemm_phase2<EpiResid, pg8::TailOrder, GEMM_ALIGN, GEMM_SP2>(lds, g, S, E); }
}
struct CvtTile { const float* src; bf16_t* dst; int ld_src, ld_dst; };
__device__ __forceinline__ CvtTile convert_desc(const Params& p, int t) {
        bf16_t* W = (bf16_t*)(p.ws + WS_W);
        const int l = t / 5120; int r = t % 5120;
        bf16_t* Wl = W + (size_t)l * WL;
        const float* src; int ld_src; bf16_t* dst; int ld_dst;
        if (r < 1408 || (r >= 3008 && r < 4416)) {
            const bool second = r >= 3008; if (second) r -= 3008;
            const int tn = r >> 4, tk = r & 15, n0 = tn * 64, pn = n0 >> 8, bj = (n0 >> 7) & 1, i0 = n0 & 127;
            const float* g = (second ? p.in[26] : p.in[3]) + (size_t)l * DM * DFF; const float* up = (second ? p.in[27] : p.in[4]) + (size_t)l * DM * DFF;
            src = (bj ? up : g) + (size_t)(tk * 64) * DFF + pn * 128 + i0; ld_src = DFF;
            dst = Wl + (second ? WO_GU2 : WO_GU1) + (size_t)n0 * DM + tk * 64; ld_dst = DM;
        } else if (r < 2112 || r >= 4416) {
            const bool second = r >= 4416; r -= second ? 4416 : 1408;
            const int tn = r / 44, tk = r % 44;
            src = (second ? p.in[28] : p.in[5]) + (size_t)l * DFF * DM + (size_t)(tk * 64) * DM + tn * 64; ld_src = DM;
            dst = Wl + (second ? WO_D2 : WO_D1) + (size_t)(tn * 64) * DFF + tk * 64; ld_dst = DFF;
        } else if (r < 2688) {
            r -= 2112; const int tn = r >> 4, tk = r & 15, n0 = tn * 64, c0 = n0 < 1792 ? n0 : n0 + 8;
            src = p.in[7] + (size_t)l * DM * INW + (size_t)(tk * 64) * INW + c0; ld_src = INW;
            dst = Wl + WO_IN + (size_t)n0 * DM + tk * 64; ld_dst = DM;
        } else if (r < 2752) {
            r -= 2688; const int tn = r >> 3, tk = r & 7;
            src = p.in[21] + (size_t)l * 512 * 512 + (size_t)(tk * 64) * 512 + tn * 64; ld_src = 512;
            dst = Wl + WO_GLU + (size_t)(tn * 64) * 512 + tk * 64; ld_dst = 512;
        } else {
            r -= 2752; const int tn = r >> 4, tk = r & 15;
            src = p.in[24] + (size_t)l * DM * DM + (size_t)(tk * 64) * DM + tn * 64; ld_src = DM;
            dst = Wl + WO_OUT + (size_t)(tn * 64) * DM + tk * 64; ld_dst = DM;
        }
        return CvtTile{src, dst, ld_src, ld_dst};
}
__device__ __forceinline__ void convert_weights(const Params& p, LAS unsigned char* lds) {
    LAS float* T = (LAS float*)lds;
    const int tid = otid(), kr = tid >> 4, c4 = (tid & 15) * 4, n = tid >> 3, k8 = (tid & 7) * 8;
    int t = obid();
    if (t >= 2 * 5120) return;
    CvtTile cur = convert_desc(p, t);
    f32x4 v0 = *(const f32x4*)(cur.src + (size_t)kr * cur.ld_src + c4), v1 = *(const f32x4*)(cur.src + (size_t)(kr + 32) * cur.ld_src + c4);
    for (;;) {
        const int tn = t + (int)gridDim.x; const bool has = tn < 2 * 5120;
        CvtTile nxt = cur; f32x4 w0 = v0, w1 = v1;
        if (has) { nxt = convert_desc(p, tn); w0 = *(const f32x4*)(nxt.src + (size_t)kr * nxt.ld_src + c4); w1 = *(const f32x4*)(nxt.src + (size_t)(kr + 32) * nxt.ld_src + c4); }
        T[kr * 65 + c4 + 0] = v0[0]; T[kr * 65 + c4 + 1] = v0[1]; T[kr * 65 + c4 + 2] = v0[2]; T[kr * 65 + c4 + 3] = v0[3];
        T[(kr + 32) * 65 + c4 + 0] = v1[0]; T[(kr + 32) * 65 + c4 + 1] = v1[1]; T[(kr + 32) * 65 + c4 + 2] = v1[2]; T[(kr + 32) * 65 + c4 + 3] = v1[3];
        __syncthreads();
        { u32x4 w;
          w.x = pack2(T[(k8 + 0) * 65 + n], T[(k8 + 1) * 65 + n]); w.y = pack2(T[(k8 + 2) * 65 + n], T[(k8 + 3) * 65 + n]);
          w.z = pack2(T[(k8 + 4) * 65 + n], T[(k8 + 5) * 65 + n]); w.w = pack2(T[(k8 + 6) * 65 + n], T[(k8 + 7) * 65 + n]);
          *(u32x4*)(cur.dst + (size_t)n * cur.ld_dst + k8) = w; }
        __syncthreads();
        if (!has) break;
        cur = nxt; v0 = w0; v1 = w1; t = tn;
    }
}
__device__ __forceinline__ void s5_params(const Params& p) {
    const int gt = obid() * NTHR + otid();
    if (gt >= 2 * 32 * 64) return;
    const int l = gt >> 11, g = (gt >> 6) & 31, q = gt & 63;
    float* P = (float*)(p.ws + WS_S5P) + (size_t)l * S5P_L;
    const float are = p.in[13][gt], aim = p.in[14][gt], dt = expf(p.in[15][l * 32 + g]);
    const float mag = expf(are * dt), ar = mag * cosf(aim * dt), ai = mag * sinf(aim * dt);
    P[(g * 64 + q) * 2] = ar; P[(g * 64 + q) * 2 + 1] = ai;
    float pr = ar, pi = ai;
#pragma unroll
    for (int i = 0; i < 6; ++i) { const float nr = pr * pr - pi * pi, ni = 2.f * pr * pi; pr = nr; pi = ni; }
    P[4096 + (g * 64 + q) * 2] = pr; P[4096 + (g * 64 + q) * 2 + 1] = pi;
    const float nre = ar - 1.f, nim = ai, den = 1.f / (are * are + aim * aim);
    const float cr = (nre * are + nim * aim) * den, ci = (nim * are - nre * aim) * den;
    const float* bre = p.in[16] + (size_t)gt * 16; const float* bim = p.in[17] + (size_t)gt * 16;
#pragma unroll
    for (int c = 0; c < 16; ++c) { const float br = bre[c], bi = bim[c];
        P[8192 + ((g * 16 + c) * 64 + q) * 2] = cr * br - ci * bi; P[8192 + ((g * 16 + c) * 64 + q) * 2 + 1] = cr * bi + ci * br; }
}

template <int MODE> __device__ __forceinline__ void norm_rows(const Params& p, LAS unsigned char* lds, const float* gain, int layer) {
    const int tid = otid(), lane = tid & 63, wid = tid >> 6;
    float* H = (float*)(p.ws + WS_H); bf16_t* XN = (bf16_t*)(p.ws + WS_XN);
    LAS float* wba = (LAS float*)lds;
    if (MODE == 1) {
        const float* win = p.in[7] + (size_t)layer * DM * INW;
        for (int i = tid; i < 2048; i += NTHR) { const int k = i >> 1, h = i & 1; const f32x4 v = *(const f32x4*)(win + (size_t)k * INW + 1792 + 4 * h);
            wba[k * 8 + 4 * h + 0] = v[0]; wba[k * 8 + 4 * h + 1] = v[1]; wba[k * 8 + 4 * h + 2] = v[2]; wba[k * 8 + 4 * h + 3] = v[3]; }
        __syncthreads();
    }
    for (int row0 = obid() * 8 + wid; row0 < MROWS; row0 += gridDim.x * 16) {
        f32x4 vv[2][4];
#pragma unroll
        for (int k2 = 0; k2 < 2; ++k2) {
            const int row = row0 + k2 * (int)gridDim.x * 8;
            if (row < MROWS) {
                const int b = row / LP, posb = row - b * LP; (void)b; (void)posb;
                f32x4 (&v)[4] = vv[k2];
                if (MODE == 3) {
                    const float* src = nullptr;
                    if (posb >= 128) src = p.in[0] + ((size_t)b * SEQ + (posb - 128)) * DM; else if (posb >= PADF) src = p.in[1] + (size_t)(posb - PADF) * DM;
#pragma unroll
                    for (int i = 0; i < 4; ++i) { v[i] = src ? *(const f32x4*)(src + (lane + 64 * i) * 4) : (f32x4){0.f, 0.f, 0.f, 0.f}; *(f32x4*)(H + (size_t)row * DM + (lane + 64 * i) * 4) = v[i]; }
                } else {
#pragma unroll
                    for (int i = 0; i < 4; ++i) v[i] = *(const f32x4*)(H + (size_t)row * DM + (lane + 64 * i) * 4);
                }
            }
        }
#pragma unroll
        for (int k2 = 0; k2 < 2; ++k2) {
            const int row = row0 + k2 * (int)gridDim.x * 8;
            if (row < MROWS) {
                const int b = row / LP, posb = row - b * LP; (void)b; (void)posb;
                f32x4 (&v)[4] = vv[k2];
                float ss = 0.f;
#pragma unroll
                for (int i = 0; i < 4; ++i) ss += v[i][0] * v[i][0] + v[i][1] * v[i][1] + v[i][2] * v[i][2] + v[i][3] * v[i][3];
#pragma unroll
                for (int d = 1; d < 64; d <<= 1) ss += __shfl_xor(ss, d);
                const float rstd = rsqrtf(ss * (1.f / 1024.f) + 1e-6f);
                float ba[8];
#pragma unroll
                for (int e = 0; e < 8; ++e) ba[e] = 0.f;
#pragma unroll
                for (int i = 0; i < 4; ++i) {
                    const f32x4 g4 = *(const f32x4*)(gain + (lane + 64 * i) * 4);
                    const f32x4 y = v[i] * g4 * rstd;
                    if (MODE == 2) { if (posb >= 128) *(f32x4*)(p.out + ((size_t)b * SEQ + (posb - 128)) * DM + (lane + 64 * i) * 4) = y; }
                    else { u32x2 w; w.x = pack2(y[0], y[1]); w.y = pack2(y[2], y[3]); *(u32x2*)(XN + (size_t)row * DM + (lane + 64 * i) * 4) = w; }
                    if (MODE == 1) {
#pragma unroll
                        for (int j = 0; j < 4; ++j) { const int k = (lane + 64 * i) * 4 + j;
#pragma unroll
                            for (int e = 0; e < 8; ++e) ba[e] += y[j] * wba[k * 8 + e]; }
                    }
                }
                if (MODE == 1) {
#pragma unroll
                    for (int e = 0; e < 8; ++e) {
#pragma unroll
                        for (int d = 1; d < 64; d <<= 1) ba[e] += __shfl_xor(ba[e], d); }
                    if (lane == 0) { float* o = (float*)(p.ws + WS_BA) + (size_t)row * 8;
#pragma unroll
                        for (int e = 0; e < 8; ++e) o[e] = ba[e]; }
                }

            }
        }
    }
    if (MODE == 1) __syncthreads();
}

#define XB_TMO      128
#define XB_XCNT(j)  (256  + 64 * (j))
#define XB_XSUB(j)  (1280 + 64 * (j))
#define XB_XGEN(j)  (2304 + 64 * (j))
#define XB_TOP      3328
#define XB_TOPGEN   3392
#define XCD_BAR_WORDS 3456
#define XB_SPIN_CAP (1u << 18)

__device__ __forceinline__ unsigned xb_ld(unsigned* p)              { return __hip_atomic_load(p, __ATOMIC_RELAXED, __HIP_MEMORY_SCOPE_AGENT); }
__device__ __forceinline__ unsigned xb_add(unsigned* p, unsigned v) { return __hip_atomic_fetch_add(p, v, __ATOMIC_RELAXED, __HIP_MEMORY_SCOPE_AGENT); }
__device__ __forceinline__ unsigned xb_xcc_id() { return (unsigned)__builtin_amdgcn_s_getreg((3 << 11) | 20) & 0xFu; }
#define XB_SPIN(cond, bar) do { unsigned _sp = 0; while (cond) { __builtin_amdgcn_s_sleep(1); \
    if ((++_sp & 255u) == 0u) { if (xb_ld(&(bar)[XB_TMO])) break; if (_sp > XB_SPIN_CAP) { atomicAdd(&(bar)[XB_TMO], 1u); break; } } } } while (0)

struct XcdBarrier {
    unsigned* bar; unsigned x;
    volatile LAS unsigned* st;
};

__device__ __forceinline__ XcdBarrier xcd_barrier_post(unsigned* bar, volatile LAS unsigned* st) {
    XcdBarrier b; b.bar = bar; b.x = xb_xcc_id(); b.st = st;
    if (otid() == 0) (void)xb_add(&bar[XB_XCNT(b.x)], 1u);
    return b;
}
__device__ __forceinline__ void xcd_barrier_complete(unsigned* bar, unsigned x, unsigned& nloc, unsigned& nx) {
    const unsigned G = gridDim.x * gridDim.y * gridDim.z;
    unsigned sum, cnt, mine, sp = 0u;
    for (;;) {
        sum = 0u; cnt = 0u; mine = 0u;
#pragma unroll
        for (unsigned j = 0; j < 16; ++j) { const unsigned c = xb_ld(&bar[XB_XCNT(j)]); sum += c; cnt += (c > 0u) ? 1u : 0u; mine = (j == x) ? c : mine; }
        if (sum == G) break;
        __builtin_amdgcn_s_sleep(1);
        if ((++sp & 255u) == 0u) { if (xb_ld(&bar[XB_TMO])) break; if (sp > XB_SPIN_CAP) { atomicAdd(&bar[XB_TMO], 1u); break; } }
    }
    nloc = mine > 0u ? mine : 1u; nx = cnt > 0u ? cnt : 1u;
}

__device__ __forceinline__ void xcd_barrier(const XcdBarrier& b) {
    asm volatile("s_waitcnt vmcnt(0)" ::: "memory");
    __syncthreads();
    if (otid() == 0) {
        unsigned* bar = b.bar;
        __builtin_amdgcn_s_waitcnt(0);
        unsigned nloc = b.st[0], nx = b.st[1];
        if (nloc == 0u) { xcd_barrier_complete(bar, b.x, nloc, nx); b.st[0] = nloc; b.st[1] = nx; }
        const unsigned old = xb_add(&bar[XB_XSUB(b.x)], 1u);
        const unsigned gen = old / nloc;
        if (old + 1u == (gen + 1u) * nloc) {
            __builtin_amdgcn_fence(__ATOMIC_RELEASE, "agent");
            asm volatile("s_waitcnt vmcnt(0)" ::: "memory");
            const unsigned og = xb_add(&bar[XB_TOP], 1u);
            const unsigned tg = og / nx;
            if (og + 1u == (tg + 1u) * nx) xb_add(&bar[XB_TOPGEN], 1u);
            else XB_SPIN(xb_ld(&bar[XB_TOPGEN]) == tg, bar);
            __builtin_amdgcn_fence(__ATOMIC_ACQUIRE, "agent");
            xb_add(&bar[XB_XGEN(b.x)], 1u);
            asm volatile("s_waitcnt vmcnt(0)" ::: "memory");
        } else {
            XB_SPIN(xb_ld(&bar[XB_XGEN(b.x)]) == gen, bar);
            __builtin_amdgcn_fence(__ATOMIC_ACQUIRE, "agent");
            asm volatile("s_waitcnt vmcnt(0)" ::: "memory");
        }
    }
    __syncthreads();
}


template <int N> __device__ __forceinline__ float row_shl(float v) { return __int_as_float(__builtin_amdgcn_update_dpp(0, __float_as_int(v), 0x100 + N, 0xf, 0xf, true)); }
__device__ __forceinline__ void sb_item(LAS unsigned char* lds, int item, const bf16_t* proj, bf16_t* mixed, const float* gain) {
    const int tid = otid(), lane = tid & 63, wid = tid >> 6, fr = lane & 15, fq = lane >> 4;
    const int qb = item % NQB, bh = item / NQB, b = bh >> 2, hd = bh & 3;
    LAS bf16_t* Qs = (LAS bf16_t*)lds;
    LAS bf16_t* Ks = Qs + 128 * 72;
    LAS bf16_t* Vt = Ks + 128 * 72;
    LAS bf16_t* Ps = Vt + 64 * 136 + wid * (16 * 136);
    const size_t rowbase = (size_t)b * LP;
    { const int r = tid >> 2, seg = tid & 3;
      const bf16_t* src = proj + (rowbase + (size_t)qb * 128 + r) * PW + hd * 64 + seg * 16;
      const u32x4 v0 = *(const u32x4*)src, v1 = *(const u32x4*)(src + 8);
      *(LAS u32x4*)(Qs + r * 72 + seg * 16) = v0; *(LAS u32x4*)(Qs + r * 72 + seg * 16 + 8) = v1; }
    f32x4 o[4];
#pragma unroll
    for (int i = 0; i < 4; ++i) o[i] = (f32x4){0.f, 0.f, 0.f, 0.f};
    float carry[4] = {0.f, 0.f, 0.f, 0.f};
    bf16x8 qa[2];
    u32x4 k0, k1, v0, v1;
    { const int r = tid >> 2, seg = tid & 3;
      const bf16_t* srck = proj + (rowbase + (size_t)qb * 128 + r) * PW + 256 + hd * 64 + seg * 16;
      k0 = *(const u32x4*)srck; k1 = *(const u32x4*)(srck + 8); v0 = *(const u32x4*)(srck + 256); v1 = *(const u32x4*)(srck + 264); }
    for (int kb = qb; kb >= 0; --kb) {
        { const int r = tid >> 2, seg = tid & 3;
          *(LAS u32x4*)(Ks + r * 72 + seg * 16) = k0; *(LAS u32x4*)(Ks + r * 72 + seg * 16 + 8) = k1;
          LAS bf16_t* vt = Vt + (seg * 16) * 136 + r;
          vt[0 * 136] = (bf16_t)(v0.x & 0xffff); vt[1 * 136] = (bf16_t)(v0.x >> 16); vt[2 * 136] = (bf16_t)(v0.y & 0xffff); vt[3 * 136] = (bf16_t)(v0.y >> 16);
          vt[4 * 136] = (bf16_t)(v0.z & 0xffff); vt[5 * 136] = (bf16_t)(v0.z >> 16); vt[6 * 136] = (bf16_t)(v0.w & 0xffff); vt[7 * 136] = (bf16_t)(v0.w >> 16);
          vt[8 * 136] = (bf16_t)(v1.x & 0xffff); vt[9 * 136] = (bf16_t)(v1.x >> 16); vt[10 * 136] = (bf16_t)(v1.y & 0xffff); vt[11 * 136] = (bf16_t)(v1.y >> 16);
          vt[12 * 136] = (bf16_t)(v1.z & 0xffff); vt[13 * 136] = (bf16_t)(v1.z >> 16); vt[14 * 136] = (bf16_t)(v1.w & 0xffff); vt[15 * 136] = (bf16_t)(v1.w >> 16); }
        __syncthreads();
        if (kb > 0) { const int r = tid >> 2, seg = tid & 3;
            const bf16_t* srck = proj + (rowbase + (size_t)(kb - 1) * 128 + r) * PW + 256 + hd * 64 + seg * 16;
            k0 = *(const u32x4*)srck; k1 = *(const u32x4*)(srck + 8); v0 = *(const u32x4*)(srck + 256); v1 = *(const u32x4*)(srck + 264); }
        if (kb == qb) {
#pragma unroll
            for (int ks = 0; ks < 2; ++ks) qa[ks] = *(const LAS bf16x8*)(Qs + (wid * 16 + fr) * 72 + ks * 32 + fq * 8);
        }
        f32x4 z[8];
#pragma unroll
        for (int f = 0; f < 8; ++f) { z[f] = (f32x4){0.f, 0.f, 0.f, 0.f};
#pragma unroll
            for (int ks = 0; ks < 2; ++ks) { const bf16x8 kf = *(const LAS bf16x8*)(Ks + (f * 16 + fr) * 72 + ks * 32 + fq * 8); z[f] = mfma16(qa[ks], kf, z[f]); } }
        const int qpos0 = qb * 128 + wid * 16 + fq * 4;
        float lk[8][4];
#pragma unroll
        for (int f = 0; f < 8; ++f) { const int kpos = kb * 128 + f * 16 + fr;
#pragma unroll
            for (int r = 0; r < 4; ++r) { const bool valid = (kpos < qpos0 + r) & (kpos >= PADF);
                const float zs = z[f][r] * 0.125f; z[f][r] = zs; const float sp = softplus_fast(zs); float v = valid ? -sp : 0.f;
                v += row_shl<1>(v); v += row_shl<2>(v); v += row_shl<4>(v); v += row_shl<8>(v);
                lk[f][r] = v; } }
#pragma unroll
        for (int r = 0; r < 4; ++r) { float run = carry[r];
#pragma unroll
            for (int f = 7; f >= 0; --f) { const int kpos = kb * 128 + f * 16 + fr; const bool valid = (kpos < qpos0 + r) & (kpos >= PADF);
                const float tot = __shfl(lk[f][r], 0, 16);
                const float ew = __expf(fminf(z[f][r] + lk[f][r] + run, 0.f));
                const float w = valid ? ew : 0.f;
                run += tot;
                Ps[(fq * 4 + r) * 136 + f * 16 + fr] = f2bf(w); }
            carry[r] = run; }
        WAVE_LDS_SYNC();
#pragma unroll
        for (int ks = 0; ks < 4; ++ks) { const bf16x8 pa = *(const LAS bf16x8*)(Ps + fr * 136 + ks * 32 + fq * 8);
#pragma unroll
            for (int df = 0; df < 4; ++df) { const bf16x8 vb = *(const LAS bf16x8*)(Vt + (df * 16 + fr) * 136 + ks * 32 + fq * 8); o[df] = mfma16(pa, vb, o[df]); } }
        const bool wdone = (carry[0] < -60.f) && (carry[1] < -60.f) && (carry[2] < -60.f) && (carry[3] < -60.f);
        const int cont = __syncthreads_or(wdone ? 0 : 1);
        if (!cont) break;
    }
#pragma unroll
    for (int r = 0; r < 4; ++r) { float ss = 0.f;
#pragma unroll
        for (int df = 0; df < 4; ++df) ss += o[df][r] * o[df][r];
#pragma unroll
        for (int d = 1; d < 16; d <<= 1) ss += __shfl_xor(ss, d, 16);
        const float rstd = rsqrtf(ss * (1.f / 64.f) + 1e-6f);
        bf16_t* dst = mixed + (rowbase + (size_t)qb * 128 + wid * 16 + fq * 4 + r) * DM + hd * 64;
#pragma unroll
        for (int df = 0; df < 4; ++df) dst[df * 16 + fr] = f2bf(o[df][r] * rstd * gain[df * 16 + fr]); }
}

struct DNBufs { bf16_t* W; bf16_t* QG; bf16_t* ATT; bf16_t* KT; bf16_t* UT; float* EGL; float* ODN; };
__device__ __forceinline__ DNBufs dn_bufs(const Params& p) {
    unsigned char* o = (unsigned char*)p.out;
    return DNBufs{(bf16_t*)(o + DO_W), (bf16_t*)(o + DO_QG), (bf16_t*)(o + DO_ATT), (bf16_t*)(o + DO_KT), (bf16_t*)(o + DO_UT), (float*)(o + DO_EGL), (float*)(o + DO_ODN)};
}
__device__ __forceinline__ void dn_local_item(const Params& p, LAS unsigned char* lds, int item, int layer, const bf16_t* proj, const DNBufs& D) {
    const int tid = otid(), lane = tid & 63, wid = tid >> 6, fr = lane & 15, fq = lane >> 4;
    const int n = item % NCH, bh = item / NCH, b = bh >> 2, hd = bh & 3;
    LAS float* Qf = (LAS float*)lds;
    LAS float* Kf = Qf + 64 * 65;
    LAS float* Vf = Kf + 64 * 65;
    LAS float* Lm = Vf + 64 * 65;
    LAS float* gcs = Lm + 64 * 68;
    LAS float* bts = gcs + 64;
    LAS float* scw = bts + 64;
    LAS bf16_t* Qb = (LAS bf16_t*)(scw + 64);
    LAS bf16_t* Kb = Qb + 64 * 72;
    LAS bf16_t* KTs = Kb + 64 * 72;
    LAS bf16_t* ATs = KTs + 64 * 72;
    LAS bf16_t* WTs = ATs + 64 * 72;
    LAS bf16_t* UTs = WTs + 64 * 72;
    const float* cw = p.in[9] + (size_t)layer * 4 * 768;
    const size_t pos0 = (size_t)b * LP + (size_t)n * 64;
    if (tid < 384) {
        const int cc = tid % 192, rg = tid / 192, which = cc >> 6, d = cc & 63, ch = which * 256 + hd * 64 + d;
        LAS float* dst = (which == 0 ? Qf : (which == 1 ? Kf : Vf)) + d;
        const float w0 = cw[ch], w1 = cw[768 + ch], w2 = cw[2 * 768 + ch], w3 = cw[3 * 768 + ch];
        const int r0 = rg * 32;
        if (n * 64 + r0 + 31 < PADF) {
#pragma unroll
            for (int i = 0; i < 32; ++i) dst[(r0 + i) * 65] = 0.f;
        } else {
            const bf16_t* src = proj + (pos0 + r0) * PW + 768 + ch;
            bf16_t xv[35];
#pragma unroll
            for (int i = 0; i < 35; ++i) xv[i] = src[((long)i - 3) * PW];
#pragma unroll
            for (int i = 0; i < 32; ++i) {
                const float a = w0 * bf2f(xv[i]) + w1 * bf2f(xv[i + 1]) + w2 * bf2f(xv[i + 2]) + w3 * bf2f(xv[i + 3]);
                dst[(r0 + i) * 65] = silu_fast(a) * ((n * 64 + r0 + i >= PADF) ? 1.f : 0.f);
            }
        }
    }
    if (tid < 64) {
        const int posb = n * 64 + tid; float g = 0.f, bt = 0.f;
        if (posb >= PADF) { const float* bar = (const float*)(p.ws + WS_BA) + (pos0 + tid) * 8;
            bt = 1.f / (1.f + __expf(-bar[hd]));
            const float x = bar[4 + hd] + p.in[11][layer * 4 + hd];
            g = -__expf(p.in[10][layer * 4 + hd]) * softplus_fast(x); }
        float c = g;
#pragma unroll
        for (int d = 1; d < 64; d <<= 1) { const float t = __shfl_up(c, d); if (lane >= d) c += t; }
        gcs[tid] = c; bts[tid] = bt; scw[tid] = bt * __expf(c);
    }
    __syncthreads();
    {
        const int row = tid >> 2, part = tid & 3, r = row & 63;
        LAS float* X = ((row >> 6) ? Kf : Qf) + r * 65 + part * 16; LAS bf16_t* Xb = ((row >> 6) ? Kb : Qb) + r * 72 + part * 16;
        float xv[16]; float ss = 0.f;
#pragma unroll
        for (int j = 0; j < 16; ++j) { xv[j] = X[j]; ss += xv[j] * xv[j]; }
        ss += __shfl_xor(ss, 1); ss += __shfl_xor(ss, 2);
        const float rs = rsqrtf(ss + 1e-6f);
#pragma unroll
        for (int j = 0; j < 16; j += 2) { const float a0 = xv[j] * rs, a1 = xv[j + 1] * rs; X[j] = a0; X[j + 1] = a1; *(LAS unsigned*)(Xb + j) = pack2(a0, a1); }
    }
    __syncthreads();
    const size_t ob = (size_t)item * 4096;
    const float glast = gcs[63];
#pragma unroll
    for (int idx = tid; idx < 4096; idx += NTHR) {
        const int hi = idx >> 6, lo = idx & 63;
        KTs[hi * 72 + lo] = f2bf(Kf[lo * 65 + hi] * __expf(glast - gcs[lo]));
    }
    if (tid == 0) D.EGL[item] = __expf(glast);
#pragma unroll
    for (int q4 = 0; q4 < 4; ++q4) {
        const int fid = wid * 4 + q4, gram = fid >> 4, fi = (fid >> 2) & 3, fj = fid & 3;
        LAS bf16_t* X = gram ? Qb : Kb;
        f32x4 acc = (f32x4){0.f, 0.f, 0.f, 0.f};
#pragma unroll
        for (int ks = 0; ks < 2; ++ks) { const bf16x8 a = *(const LAS bf16x8*)(X + (fi * 16 + fr) * 72 + ks * 32 + fq * 8);
            const bf16x8 bb = *(const LAS bf16x8*)(Kb + (fj * 16 + fr) * 72 + ks * 32 + fq * 8); acc = mfma16(a, bb, acc); }
        const int j = fj * 16 + fr; const float gj = gcs[j];
#pragma unroll
        for (int r = 0; r < 4; ++r) { const int i = fi * 16 + fq * 4 + r;
            const float de_ = __expf(fminf(gcs[i] - gj, 0.f)); const float dec = (i >= j) ? de_ : 0.f;
            if (gram == 0) Lm[i * 68 + j] = (i > j) ? bts[i] * acc[r] * dec : 0.f;
            else ATs[i * 72 + j] = f2bf(acc[r] * 0.125f * dec); }
    }
    __syncthreads();
    if (tid < 128) {
        const int col = tid & 63; const bool isw = tid >= 64;
        LAS float* X = (isw ? Kf : Vf) + col;
        const LAS float* sc = isw ? scw : bts;
        float x[64];
#pragma unroll
        for (int I = 0; I < 4; ++I) {
            float r[16];
#pragma unroll
            for (int ii = 0; ii < 16; ++ii) { const int i = I * 16 + ii; r[ii] = X[i * 65] * sc[i]; }
            asm volatile("" ::: "memory");
#pragma unroll
            for (int J = 0; J < I; ++J) {
#pragma unroll
                for (int ii = 0; ii < 16; ++ii) { const int i = I * 16 + ii;
#pragma unroll
                    for (int j4 = 0; j4 < 4; ++j4) { const f32x4 l4 = *(const LAS f32x4*)(Lm + i * 68 + J * 16 + j4 * 4);
                        r[ii] -= l4[0] * x[J * 16 + j4 * 4] + l4[1] * x[J * 16 + j4 * 4 + 1] + l4[2] * x[J * 16 + j4 * 4 + 2] + l4[3] * x[J * 16 + j4 * 4 + 3]; }
                    if ((ii & 3) == 3) asm volatile("" ::: "memory");
                }
            }
#pragma unroll
            for (int ii = 0; ii < 16; ++ii) { const int i = I * 16 + ii; float sacc = r[ii];
#pragma unroll
                for (int jj = 0; jj < ii; ++jj) sacc -= Lm[i * 68 + I * 16 + jj] * x[I * 16 + jj];
                x[i] = sacc; X[i * 65] = sacc;
                if ((ii & 3) == 3) asm volatile("" ::: "memory");
            }
        }
    }
    __syncthreads();
#pragma unroll
    for (int idx = tid; idx < 4096; idx += NTHR) {
        const int hi = idx >> 6, lo = idx & 63;
        WTs[hi * 72 + lo] = f2bf(Kf[lo * 65 + hi]);
        UTs[hi * 72 + lo] = f2bf(Vf[lo * 65 + hi]);
    }
    __syncthreads();
    {   const int mt = wid >> 1, half = wid & 1;
        const LAS bf16_t* Xs = (mt == 0 || mt == 2) ? KTs : ATs;
        const LAS bf16_t* Ys = mt < 2 ? WTs : UTs;
        bf16_t* dstp = mt == 0 ? D.W : (mt == 1 ? D.QG : (mt == 2 ? D.ATT : D.KT));
#pragma unroll
        for (int q8 = 0; q8 < 8; ++q8) {
            const int fi = half * 2 + (q8 >> 2), fj = q8 & 3;
            f32x4 acc = (f32x4){0.f, 0.f, 0.f, 0.f};
#pragma unroll
            for (int ks = 0; ks < 2; ++ks) acc = mfma16(*(const LAS bf16x8*)(Xs + (fi * 16 + fr) * 72 + ks * 32 + fq * 8), *(const LAS bf16x8*)(Ys + (fj * 16 + fr) * 72 + ks * 32 + fq * 8), acc);
            if (mt == 0) {
#pragma unroll
                for (int r = 0; r < 4; ++r) dstp[ob + (fi * 16 + fq * 4 + r) * 64 + fj * 16 + fr] = f2bf(-acc[r]);
            } else if (mt == 1) {
#pragma unroll
                for (int r = 0; r < 4; ++r) { const int c = fi * 16 + fq * 4 + r; dstp[ob + c * 64 + fj * 16 + fr] = f2bf(Qf[c * 65 + fj * 16 + fr] * 0.125f * __expf(gcs[c]) - acc[r]); }
            } else {
                u32x2 w; w.x = pack2(acc[0], acc[1]); w.y = pack2(acc[2], acc[3]);
                *(u32x2*)(dstp + ob + (fj * 64 + lane) * 16 + fi * 4) = w;
            }
        }
    }
    __syncthreads();
}

__device__ __forceinline__ void dn_seq_compute(const LAS bf16_t* MYs, f32x4 (&ST)[4], float egl_cur, float* odst, int dvb, int lane, int fr, int fq) {
    constexpr int MATE = 64 * 72;
    const LAS bf16_t* CYs = MYs + MATE; const LAS bf16_t* BNs = MYs + 2 * MATE; const LAS bf16_t* DNs = BNs + 4096;
    bf16x8 amy[4][2], acy[4][2];
#pragma unroll
    for (int f = 0; f < 4; ++f)
#pragma unroll
        for (int ks = 0; ks < 2; ++ks) { const int o_ = (f * 16 + fr) * 72 + ks * 32 + fq * 4;
            const u32x2 m0 = *(const LAS u32x2*)(MYs + o_), m1 = *(const LAS u32x2*)(MYs + o_ + 16), c0 = *(const LAS u32x2*)(CYs + o_), c1 = *(const LAS u32x2*)(CYs + o_ + 16);
            const u32x4 mm = {m0.x, m0.y, m1.x, m1.y}, cc = {c0.x, c0.y, c1.x, c1.y};
            amy[f][ks] = __builtin_bit_cast(bf16x8, mm); acy[f][ks] = __builtin_bit_cast(bf16x8, cc); }
    const u32x4 b0 = *(const LAS u32x4*)(BNs + (dvb * 64 + lane) * 16), b1 = *(const LAS u32x4*)(BNs + (dvb * 64 + lane) * 16 + 8);
    const u32x4 d0 = *(const LAS u32x4*)(DNs + (dvb * 64 + lane) * 16), d1 = *(const LAS u32x4*)(DNs + (dvb * 64 + lane) * 16 + 8);
    bf16x8 bop[2];
#pragma unroll
    for (int ks = 0; ks < 2; ++ks) { const u32x4 w = {pack2(ST[2 * ks][0], ST[2 * ks][1]), pack2(ST[2 * ks][2], ST[2 * ks][3]), pack2(ST[2 * ks + 1][0], ST[2 * ks + 1][1]), pack2(ST[2 * ks + 1][2], ST[2 * ks + 1][3])};
        bop[ks] = __builtin_bit_cast(bf16x8, w); }
    f32x4 o[4];
    o[0] = (f32x4){bflo(d0.x), bfhi(d0.x), bflo(d0.y), bfhi(d0.y)}; o[1] = (f32x4){bflo(d0.z), bfhi(d0.z), bflo(d0.w), bfhi(d0.w)};
    o[2] = (f32x4){bflo(d1.x), bfhi(d1.x), bflo(d1.y), bfhi(d1.y)}; o[3] = (f32x4){bflo(d1.z), bfhi(d1.z), bflo(d1.w), bfhi(d1.w)};
    ST[0] = ST[0] * egl_cur + (f32x4){bflo(b0.x), bfhi(b0.x), bflo(b0.y), bfhi(b0.y)}; ST[1] = ST[1] * egl_cur + (f32x4){bflo(b0.z), bfhi(b0.z), bflo(b0.w), bfhi(b0.w)};
    ST[2] = ST[2] * egl_cur + (f32x4){bflo(b1.x), bfhi(b1.x), bflo(b1.y), bfhi(b1.y)}; ST[3] = ST[3] * egl_cur + (f32x4){bflo(b1.z), bfhi(b1.z), bflo(b1.w), bfhi(b1.w)};
#pragma unroll
    for (int f = 0; f < 4; ++f)
#pragma unroll
        for (int ks = 0; ks < 2; ++ks) { o[f] = mfma16(acy[f][ks], bop[ks], o[f]); ST[f] = mfma16(amy[f][ks], bop[ks], ST[f]); }
#pragma unroll
    for (int cf = 0; cf < 4; ++cf)
#pragma unroll
        for (int r = 0; r < 4; ++r) odst[(size_t)(cf * 16 + fq * 4 + r) * 256 + fr] = o[cf][r];
}
struct DNStage { u32x4 r0, r1, r2, r3; };
__device__ __forceinline__ void dn_seq_block(LAS unsigned char* lds, int bh, const DNBufs& D) {
    const int tid = otid(), lane = tid & 63, wid = tid >> 6, fr = lane & 15, fq = lane >> 4;
    const int b = bh >> 2, hd = bh & 3, dvb = wid;
    constexpr int MATE = 64 * 72;
    constexpr int BUFE = 2 * MATE + 2 * 4096;
    LAS bf16_t* L0 = (LAS bf16_t*)lds;
    LAS bf16_t* STb = L0 + 2 * BUFE + wid * (16 * 72);
    LAS float* egls = (LAS float*)(L0 + 2 * BUFE + 8 * (16 * 72));
    const int goff = tid * 8, loff = (tid >> 3) * 72 + (tid & 7) * 8;
#define DN_GLOAD(S, nq) do { const int nq_ = (nq) < NCH ? (nq) : NCH - 1; const size_t ob_ = (size_t)(bh * NCH + nq_) * 4096 + goff; S.r0 = *(const u32x4*)(D.W + ob_); S.r1 = *(const u32x4*)(D.QG + ob_); \
        S.r2 = *(const u32x4*)(D.ATT + ob_); S.r3 = *(const u32x4*)(D.KT + ob_); } while (0)
#define DN_LSTORE(S, bq) do { LAS bf16_t* B_ = L0 + (bq) * BUFE; *(LAS u32x4*)(B_ + loff) = S.r0; *(LAS u32x4*)(B_ + MATE + loff) = S.r1; *(LAS u32x4*)(B_ + 2 * MATE + goff) = S.r2; \
        *(LAS u32x4*)(B_ + 2 * MATE + 4096 + goff) = S.r3; } while (0)
    DNStage s0, s1, s2;
    if (tid < NCH) egls[tid] = D.EGL[bh * NCH + tid];
    DN_GLOAD(s0, 0); DN_LSTORE(s0, 0);
    DN_GLOAD(s0, 1); DN_GLOAD(s1, 2); DN_GLOAD(s2, 3);
    __syncthreads();
    f32x4 ST[4];
#pragma unroll
    for (int f = 0; f < 4; ++f) ST[f] = (f32x4){0.f, 0.f, 0.f, 0.f};
#define DN_STEP(n, S) do { \
        DN_LSTORE(S, ((n) + 1) & 1); DN_GLOAD(S, (n) + 4); \
        if (wid < 4) dn_seq_compute(L0 + ((n) & 1) * BUFE, ST, egls[n], D.ODN + ((size_t)b * LP + (size_t)(n) * 64) * 256 + hd * 64 + dvb * 16, dvb, lane, fr, fq); \
        asm volatile("s_waitcnt lgkmcnt(0)" ::: "memory"); __builtin_amdgcn_s_barrier(); asm volatile("" ::: "memory"); } while (0)
    for (int n = 0; n < NCH; n += 3) { DN_STEP(n, s0); DN_STEP(n + 1, s1); DN_STEP(n + 2, s2); }
#undef DN_STEP
#undef DN_GLOAD
#undef DN_LSTORE
}

struct S5Coef { float ar, ai; bf16x8 are[4], aim[4]; bf16x8 cmb[4]; float dd; };
template <bool FINAL> __device__ __forceinline__ void s5_load_coef(const Params& p, int layer, int g, S5Coef& K) {
    const int lane = otid() & 63, fr = lane & 15, fq = lane >> 4;
    const float* P = (const float*)(p.ws + WS_S5P) + (size_t)layer * S5P_L;
    K.ar = P[(g * 64 + lane) * 2]; K.ai = P[(g * 64 + lane) * 2 + 1];
#pragma unroll
    for (int pf = 0; pf < 4; ++pf) { bf16x8 tr, ti;
#pragma unroll
        for (int j = 0; j < 8; ++j) { const int c = (fq & 1) * 8 + j; const float* q = P + 8192 + ((g * 16 + c) * 64 + pf * 16 + fr) * 2;
            tr[j] = (short)f2bf(fq < 2 ? q[0] : 0.f); ti[j] = (short)f2bf(fq < 2 ? q[1] : 0.f); }
        K.are[pf] = tr; K.aim[pf] = ti; }
    K.dd = 0.f;
    if (FINAL) {
        const float* cre = p.in[18] + ((size_t)(layer * 32 + g) * 16 + fr) * 64; const float* cim = p.in[19] + ((size_t)(layer * 32 + g) * 16 + fr) * 64;
#pragma unroll
        for (int kk = 0; kk < 4; ++kk) { bf16x8 t;
#pragma unroll
            for (int j = 0; j < 8; ++j) { const int k = (kk & 1) * 32 + fq * 8 + j; t[j] = (short)f2bf(kk < 2 ? cre[k] : -cim[k]); }
            K.cmb[kk] = t; }
        K.dd = p.in[20][layer * 512 + g * 16 + fr];
    }
}
constexpr int S5_LDSW = 13056;
__device__ __forceinline__ void s5_load_u(const bf16_t* proj, int item, u32x4& v0, u32x4& v1) {
    const int lane = otid() & 63, g = item & 31, bn = item >> 5, n = bn % NCH, b = bn / NCH;
    const bf16_t* src = proj + ((size_t)b * LP + (size_t)n * 64 + lane) * PW + 1792 + g * 16;
    v0 = *(const u32x4*)src; v1 = *(const u32x4*)(src + 8);
}
template <bool FINAL> __device__ __forceinline__ void s5_item(const Params& p, LAS unsigned char* ldsw, int item, int layer, const bf16_t* proj, const S5Coef& K, const u32x4 v0, const u32x4 v1) {
    const int lane = otid() & 63, fr = lane & 15, fq = lane >> 4;
    const int g = item & 31, bn = item >> 5, n = bn % NCH, b = bn / NCH;
    LAS bf16_t* Ub = (LAS bf16_t*)ldsw;
    LAS bf16_t* BUr = Ub + 64 * 32;
    LAS bf16_t* BUi = BUr + 16 * 72;
    LAS bf16_t* Sb = BUi + 16 * 72;
    const size_t pos0 = (size_t)b * LP + (size_t)n * 64;
    { const u32x4 zz = {0u, 0u, 0u, 0u};
      *(LAS u32x4*)(Ub + lane * 32) = v0; *(LAS u32x4*)(Ub + lane * 32 + 8) = v1; *(LAS u32x4*)(Ub + lane * 32 + 16) = zz; *(LAS u32x4*)(Ub + lane * 32 + 24) = zz; }
    float* E = (float*)(p.ws + WS_E);
    float sr = 0.f, si = 0.f;
    if (FINAL) { const float* c = (const float*)(p.ws + WS_CIN) + ((size_t)((b * NCH + n) * 32 + g) * 64 + lane) * 2; sr = c[0]; si = c[1]; }
    WAVE_LDS_SYNC();
    bf16_t* YG = (bf16_t*)(p.ws + WS_XN);
    for (int tf = 0; tf < 4; ++tf) {
        const bf16x8 uf = *(const LAS bf16x8*)(Ub + (tf * 16 + fr) * 32 + fq * 8);
#pragma unroll
        for (int pf = 0; pf < 4; ++pf) {
            const f32x4 z4 = {0.f, 0.f, 0.f, 0.f};
            const f32x4 cr = mfma16(K.are[pf], uf, z4), ci = mfma16(K.aim[pf], uf, z4);
            u32x2 wr_, wi_; wr_.x = pack2(cr[0], cr[1]); wr_.y = pack2(cr[2], cr[3]); wi_.x = pack2(ci[0], ci[1]); wi_.y = pack2(ci[2], ci[3]);
            *(LAS u32x2*)(BUr + fr * 72 + pf * 16 + fq * 4) = wr_; *(LAS u32x2*)(BUi + fr * 72 + pf * 16 + fq * 4) = wi_;
        }
        WAVE_LDS_SYNC();
#pragma unroll
        for (int tl = 0; tl < 16; ++tl) {
            const float br = bf2f(BUr[tl * 72 + lane]), bi = bf2f(BUi[tl * 72 + lane]);
            const float nr = K.ar * sr - K.ai * si + br, ni = K.ar * si + K.ai * sr + bi; sr = nr; si = ni;
            if (FINAL) { Sb[tl * 136 + lane] = f2bf(sr); Sb[tl * 136 + 64 + lane] = f2bf(si); }
        }
        if (FINAL) {
            WAVE_LDS_SYNC();
            f32x4 y = (f32x4){0.f, 0.f, 0.f, 0.f};
#pragma unroll
            for (int kk = 0; kk < 4; ++kk) { const bf16x8 sa = *(const LAS bf16x8*)(Sb + fr * 136 + kk * 32 + fq * 8); y = mfma16(sa, K.cmb[kk], y); }
#pragma unroll
            for (int r = 0; r < 4; ++r) { const int tl = tf * 16 + fq * 4 + r;
                const float yv = y[r] + K.dd * bf2f(Ub[tl * 32 + fr]);
                const float x = 0.7978845608f * (yv + 0.044715f * yv * yv * yv);
                const float th = 1.f - 2.f * __builtin_amdgcn_rcpf(1.f + __expf(2.f * x));
                YG[(pos0 + tl) * 512 + g * 16 + fr] = f2bf(0.5f * yv * (1.f + th)); }
        }
        WAVE_LDS_SYNC();
    }
    if (!FINAL) { float* e = E + ((size_t)((b * NCH + n) * 32 + g) * 64 + lane) * 2; e[0] = sr; e[1] = si; }
}

__device__ __forceinline__ void s5_carry_scan(const Params& p, int layer) {
    const int tid = otid(), lane = tid & 63, gw = obid() * 8 + (tid >> 6);
    if (gw >= 64) return;
    const int b = gw >> 5, g = gw & 31;
    const float* P = (const float*)(p.ws + WS_S5P) + (size_t)layer * S5P_L;
    const float a64r = P[4096 + (g * 64 + lane) * 2], a64i = P[4096 + (g * 64 + lane) * 2 + 1];
    const float* E = (const float*)(p.ws + WS_E); float* C = (float*)(p.ws + WS_CIN);
    float cr = 0.f, ci = 0.f;
    static_assert(NCH % 43 == 0, "chunk groups");
    for (int n0 = 0; n0 < NCH; n0 += 43) {
        float er[43], ei[43];
#pragma unroll
        for (int k = 0; k < 43; ++k) { const float* e = E + ((size_t)((b * NCH + n0 + k) * 32 + g) * 64 + lane) * 2; er[k] = e[0]; ei[k] = e[1]; }
#pragma unroll
        for (int k = 0; k < 43; ++k) { float* c = C + ((size_t)((b * NCH + n0 + k) * 32 + g) * 64 + lane) * 2; c[0] = cr; c[1] = ci;
            const float nr = a64r * cr - a64i * ci + er[k], ni = a64r * ci + a64i * cr + ei[k]; cr = nr; ci = ni; }
    }
}

__device__ __forceinline__ void mix_finalize(const Params& p, int layer, const bf16_t* proj, bf16_t* mixed) {
    const int lane = otid() & 63, wid = otid() >> 6;
    const float* odn = (const float*)((unsigned char*)p.out + DO_ODN);
    const bf16_t* GL = (const bf16_t*)(p.ws + WS_XN) + (size_t)MROWS * 512;
    const float* gdn = p.in[12] + layer * 64; const float* gs5 = p.in[23] + layer * 512;
    for (int row = obid() * 8 + wid; row < MROWS; row += gridDim.x * 8) {
        { const f32x4 v = *(const f32x4*)(odn + (size_t)row * 256 + lane * 4);
          float ss = v[0] * v[0] + v[1] * v[1] + v[2] * v[2] + v[3] * v[3];
#pragma unroll
          for (int d = 1; d < 16; d <<= 1) ss += __shfl_xor(ss, d, 16);
          const float rstd = rsqrtf(ss * (1.f / 64.f) + 1e-6f);
          const u32x2 zz = *(const u32x2*)(proj + (size_t)row * PW + 1536 + lane * 4);
          const f32x4 gg = *(const f32x4*)(gdn + (lane & 15) * 4);
          u32x2 w; w.x = pack2(v[0] * rstd * gg[0] * silu_fast(bflo(zz.x)), v[1] * rstd * gg[1] * silu_fast(bfhi(zz.x)));
          w.y = pack2(v[2] * rstd * gg[2] * silu_fast(bflo(zz.y)), v[3] * rstd * gg[3] * silu_fast(bfhi(zz.y)));
          *(u32x2*)(mixed + (size_t)row * DM + 256 + lane * 4) = w; }
        { const u32x4 gv = *(const u32x4*)(GL + (size_t)row * 512 + lane * 8);
          float v[8] = {bflo(gv.x), bfhi(gv.x), bflo(gv.y), bfhi(gv.y), bflo(gv.z), bfhi(gv.z), bflo(gv.w), bfhi(gv.w)};
          float ss = 0.f;
#pragma unroll
          for (int j = 0; j < 8; ++j) ss += v[j] * v[j];
#pragma unroll
          for (int d = 1; d < 64; d <<= 1) ss += __shfl_xor(ss, d);
          const float rstd = rsqrtf(ss * (1.f / 512.f) + 1e-6f);
          const f32x4 g0 = *(const f32x4*)(gs5 + lane * 8), g1 = *(const f32x4*)(gs5 + lane * 8 + 4);
          u32x4 w; w.x = pack2(v[0] * rstd * g0[0], v[1] * rstd * g0[1]); w.y = pack2(v[2] * rstd * g0[2], v[3] * rstd * g0[3]);
          w.z = pack2(v[4] * rstd * g1[0], v[5] * rstd * g1[1]); w.w = pack2(v[6] * rstd * g1[2], v[7] * rstd * g1[3]);
          *(u32x4*)(mixed + (size_t)row * DM + 512 + lane * 8) = w; }
    }
}

constexpr int NPHASE = 29;
#ifndef ALIGN_UP
#define ALIGN_UP true
#endif
#ifndef ALIGN_GLU
#define ALIGN_GLU true
#endif
#ifndef ALIGN_IN
#define ALIGN_IN true
#endif
__device__ __forceinline__ void layer_phases(LAS unsigned char* lds, int lo, int hi, int L) {
#define PP() const ParamsG* pp = (const ParamsG*)__builtin_amdgcn_kernarg_segment_ptr(); asm volatile("" : "+s"(pp)); Params pl_; pl_.ws = (unsigned char*)pp->ws; pl_.out = (float*)pp->out; _Pragma("unroll") for (int i_ = 0; i_ < 30; ++i_) pl_.in[i_] = (const float*)pp->in[i_]; const Params& p = pl_; \
    float* H = (float*)(p.ws + WS_H); bf16_t* XN = (bf16_t*)(p.ws + WS_XN); bf16_t* ACT = (bf16_t*)(p.ws + WS_BIG); bf16_t* PROJ = (bf16_t*)(p.ws + WS_BIG); \
    bf16_t* MIXED = (bf16_t*)(p.ws + WS_BIG + SZ_PROJ); bf16_t* YG = XN; bf16_t* GL = XN + (size_t)MROWS * 512; const bf16_t* Wl = (const bf16_t*)(p.ws + WS_W) + (size_t)L * WL; \
    (void)H; (void)XN; (void)ACT; (void)PROJ; (void)MIXED; (void)YG; (void)GL; (void)Wl;
#define IN(k) (lo <= (k) && (k) < hi)
#define SEAM(k) do { if ((k) + 1 < hi) { if ((k) == 0) cg::this_grid().sync(); else { const ParamsG* pq = (const ParamsG*)__builtin_amdgcn_kernarg_segment_ptr(); asm volatile("" : "+s"(pq)); \
        XcdBarrier xb_; xb_.bar = (unsigned*)(unsigned char*)(pq->ws + WS_BAR); xb_.x = xb_xcc_id(); xb_.st = (volatile LAS unsigned*)(lds + 131072); xcd_barrier(xb_); } } } while (0)
    const int pb = 1 + 14 * L;
    if (IN(pb + 0)) { { PP(); EpiSwiGLU E{ACT}; run_gemm<EpiSwiGLU, ALIGN_UP>(lds, XN, Wl + WO_GU1, 2 * DFF, DM, E); } SEAM(pb + 0); }
    if (IN(pb + 1)) { { PP(); run_gemm_resid(lds, ACT, Wl + WO_D1, DM, DFF, H, 0.5f); } SEAM(pb + 1); }
    if (IN(pb + 2)) { { PP(); norm_rows<1>(p, lds, p.in[6] + L * DM, L); } SEAM(pb + 2); }
    if (IN(pb + 3)) { { PP(); EpiBf16 E{PROJ, PW}; run_gemm<EpiBf16, ALIGN_IN>(lds, XN, Wl + WO_IN, PW, DM, E); } SEAM(pb + 3); }
    if (IN(pb + 4)) { { PP(); const int wid = otid() >> 6;
        const DNBufs D = dn_bufs(p);
        int it = obid();
        for (; it < NDN; it += gridDim.x) dn_local_item(p, lds, it, L, PROJ, D);
        if (it < NDN + NDN) {
            S5Coef K; int gk = ((it - NDN) * 8 + wid) & 31; s5_load_coef<false>(p, L, gk, K);
            u32x4 un0, un1; s5_load_u(PROJ, (it - NDN) * 8 + wid, un0, un1);
            for (; it < NDN + NDN; it += gridDim.x) { const int item = (it - NDN) * 8 + wid;
                if ((item & 31) != gk) { gk = item & 31; s5_load_coef<false>(p, L, gk, K); }
                const u32x4 uc0 = un0, uc1 = un1;
                if (it + (int)gridDim.x < NDN + NDN) s5_load_u(PROJ, item + (int)gridDim.x * 8, un0, un1);
                s5_item<false>(p, lds + wid * S5_LDSW, item, L, PROJ, K, uc0, uc1); __syncthreads(); } } }
        SEAM(pb + 4); }
    if (IN(pb + 5)) { { PP(); s5_carry_scan(p, L); } SEAM(pb + 5); }
    if (IN(pb + 6)) { { PP(); const int wid = otid() >> 6;
        const DNBufs D = dn_bufs(p);
        if (obid() < 8) dn_seq_block(lds, obid(), D);
        else { int it = obid() - 8;
            for (; it < 8 * NQB; it += gridDim.x - 8) sb_item(lds, it, PROJ, MIXED, p.in[8] + L * 64);
            if (it < 8 * NQB + NDN) {
                S5Coef K; int gk = ((it - 8 * NQB) * 8 + wid) & 31; s5_load_coef<true>(p, L, gk, K);
                u32x4 un0, un1; s5_load_u(PROJ, (it - 8 * NQB) * 8 + wid, un0, un1);
                for (; it < 8 * NQB + NDN; it += gridDim.x - 8) { const int item = (it - 8 * NQB) * 8 + wid;
                    if ((item & 31) != gk) { gk = item & 31; s5_load_coef<true>(p, L, gk, K); }
                    const u32x4 uc0 = un0, uc1 = un1;
                    if (it + (int)gridDim.x - 8 < 8 * NQB + NDN) s5_load_u(PROJ, item + ((int)gridDim.x - 8) * 8, un0, un1);
                    s5_item<true>(p, lds + wid * S5_LDSW, item, L, PROJ, K, uc0, uc1); __syncthreads(); } } } }
        SEAM(pb + 6); }
    if (IN(pb + 7)) { { PP(); EpiGLU E{YG, GL, p.in[22] + L * 512}; run_gemm<EpiGLU, ALIGN_GLU>(lds, YG, Wl + WO_GLU, 512, 512, E); } SEAM(pb + 7); }
    if (IN(pb + 8)) { { PP(); mix_finalize(p, L, PROJ, MIXED); } SEAM(pb + 8); }
    if (IN(pb + 9)) { { PP(); run_gemm_resid(lds, MIXED, Wl + WO_OUT, DM, DM, H, 1.0f); } SEAM(pb + 9); }
    if (IN(pb + 10)) { { PP(); norm_rows<0>(p, lds, p.in[25] + L * DM, L); } SEAM(pb + 10); }
    if (IN(pb + 11)) { { PP(); EpiSwiGLU E{ACT}; run_gemm<EpiSwiGLU, ALIGN_UP>(lds, XN, Wl + WO_GU2, 2 * DFF, DM, E); } SEAM(pb + 11); }
    if (IN(pb + 12)) { { PP(); run_gemm_resid(lds, ACT, Wl + WO_D2, DM, DFF, H, 0.5f); } SEAM(pb + 12); }
    if (IN(pb + 13)) { { PP(); if (L == 0) norm_rows<0>(p, lds, p.in[2] + DM, 1); else norm_rows<2>(p, lds, p.in[29], 1); } SEAM(pb + 13); }
}
__global__ void __launch_bounds__(NTHR, 2) hymba_fwd(Params p_arg) {
    extern __shared__ __attribute__((aligned(16))) unsigned char smem[];
    LAS unsigned char* lds = (LAS unsigned char*)smem;
    const int lo = p_arg.ph_lo, hi = p_arg.ph_hi;
    if (otid() < 4) ((LAS unsigned*)(lds + 131072))[otid()] = 0u;
    __syncthreads();
    (void)xcd_barrier_post((unsigned*)as_global(p_arg.ws + WS_BAR), (volatile LAS unsigned*)(lds + 131072));
    constexpr int L = 0;
    if (IN(0)) { { PP(); convert_weights(p, lds); s5_params(p); norm_rows<3>(p, lds, p.in[2], 0); } SEAM(0); }
#pragma nounroll
    for (int l = 0; l < 2; ++l) { int lq = l; asm volatile("" : "+s"(lq)); layer_phases(lds, lo, hi, lq); }
#undef IN
#undef SEAM
#undef PP
}

extern "C" void kernel_launch(void* const* d_in, const int* in_sizes, int n_in, void* d_out, int out_size, void* d_ws, size_t ws_size, hipStream_t stream) {
    static int grid = 0;
    if (grid == 0) {
        if (n_in != 30 || ws_size < WS_END) { fprintf(stderr, "kernel_launch: unexpected n_in %d or ws_size %zu (need %zu)\n", n_in, ws_size, (size_t)WS_END); grid = -1; return; }
        int dev = 0, cus = 0, per_cu = 0;
        hipGetDevice(&dev);
        hipDeviceGetAttribute(&cus, hipDeviceAttributeMultiprocessorCount, dev);
        if (hipFuncSetAttribute((const void*)hymba_fwd, hipFuncAttributeMaxDynamicSharedMemorySize, LDS_BYTES) != hipSuccess) { fprintf(stderr, "kernel_launch: hipFuncSetAttribute failed\n"); grid = -1; return; }
        if (hipOccupancyMaxActiveBlocksPerMultiprocessor(&per_cu, (const void*)hymba_fwd, NTHR, LDS_BYTES) != hipSuccess || per_cu < 1) { fprintf(stderr, "kernel_launch: occupancy query gave %d\n", per_cu); per_cu = 1; }
        (void)hipGetLastError();
        grid = cus * 1;
        fprintf(stderr, "kernel_launch: cus %d per_cu %d grid %d ws %zu\n", cus, per_cu, grid, ws_size);
    }
    if (grid < 0) return;
    (void)hipMemsetAsync((unsigned char*)d_ws + WS_BAR, 0, SZ_BAR, stream);
    Params p{};
    for (int i = 0; i < 30; ++i) p.in[i] = (const float*)d_in[i];
    p.out = (float*)d_out; p.ws = (unsigned char*)d_ws;
#if SINGLE_LAUNCH
    p.ph_lo = 0; p.ph_hi = NPHASE;
    void* args[] = {&p};
    hipError_t e = hipLaunchCooperativeKernel((const void*)hymba_fwd, dim3(grid), dim3(NTHR), args, LDS_BYTES, stream);
    if (e != hipSuccess) fprintf(stderr, "cooperative launch failed: %s (grid %d)\n", hipGetErrorString(e), grid);
#else
    for (int ph = 0; ph < NPHASE; ++ph) {
        p.ph_lo = ph; p.ph_hi = ph + 1;
        hipLaunchKernelGGL(hymba_fwd, dim3(grid), dim3(NTHR), LDS_BYTES, stream, p);
    }
#endif
}
```
